# Optimizing an MI355X kernel written in HIP

```python
import jax, jax.numpy as jnp
from jax import lax
import numpy as np

D_MODEL = 1024
BATCH = 2
SEQ = 8192
DEPTH = 1

CHUNK = 64
Q_BLOCK = 128
HEAD_DIM = 64
FOX_HEADS = 8
SB_HEADS = 8
FOX_WIDTH = FOX_HEADS * HEAD_DIM
SB_WIDTH = SB_HEADS * HEAD_DIM
MIX_WIDTH = FOX_WIDTH + SB_WIDTH
IN_SPLITS = (FOX_WIDTH, FOX_WIDTH, FOX_WIDTH, FOX_WIDTH, FOX_HEADS,
             SB_WIDTH, SB_WIDTH, SB_WIDTH, SB_WIDTH)
IN_WIDTH = 4 * FOX_WIDTH + FOX_HEADS + 4 * SB_WIDTH
DEEPNORM_ALPHA = (2.0 * DEPTH) ** 0.25
DEEPNORM_BETA = (8.0 * DEPTH) ** -0.25
LN_EPS = 1e-5

kernel_name = "hybrid_fox_stickbreaking_deepnorm_adaln"


def _layer_norm(x, gain=None, bias=None):
    xf = x.astype(jnp.float32)
    mu = jnp.mean(xf, axis=-1, keepdims=True)
    var = jnp.mean(jnp.square(xf - mu), axis=-1, keepdims=True)
    y = (xf - mu) * lax.rsqrt(var + LN_EPS)
    if gain is not None:
        y = y * gain.astype(jnp.float32) + bias.astype(jnp.float32)
    return y


def _split_columns(h):
    outs, off = [], 0
    for w in IN_SPLITS:
        outs.append(h[..., off:off + w])
        off += w
    return outs


def _to_heads(t, n_heads):
    b, s, _ = t.shape
    return t.reshape(b, s, n_heads, HEAD_DIM).transpose(0, 2, 1, 3)


def _from_heads(t):
    b, h, s, d = t.shape
    return t.transpose(0, 2, 1, 3).reshape(b, s, h * d)


def _fox_block(q, k, v, f_q, f_k, q_pos, k_pos):
    scale = HEAD_DIM ** -0.5
    s = jnp.einsum('bhqd,bhkd->bhqk', q, k).astype(jnp.float32) * scale
    s = s + (f_q[..., :, None] - f_k[..., None, :])
    causal = k_pos[None, :] <= q_pos[:, None]
    s = jnp.where(causal, s, -jnp.inf)
    p = jax.nn.softmax(s, axis=-1)
    return jnp.einsum('bhqk,bhkd->bhqd', p.astype(v.dtype), v)


def _stick_breaking_block(q, k, v, q_pos, k_pos):
    scale = HEAD_DIM ** -0.5
    z = jnp.einsum('bhqd,bhkd->bhqk', q, k).astype(jnp.float32) * scale
    strict = k_pos[None, :] < q_pos[:, None]
    log_beta = jax.nn.log_sigmoid(z)
    log_keep = jnp.where(strict, jax.nn.log_sigmoid(-z), 0.0)
    later = lax.cumsum(log_keep, axis=3, reverse=True) - log_keep
    w = jnp.where(strict, jnp.exp(log_beta + later), 0.0)
    return jnp.einsum('bhqk,bhkd->bhqd', w.astype(v.dtype), v)


def setup_inputs(seed: int = 0) -> dict:
    key = jax.random.key(seed)
    ks = jax.random.split(key, 16)
    x = jax.random.normal(ks[0], (BATCH, SEQ, D_MODEL), jnp.float32)
    c = jax.random.normal(ks[1], (BATCH, D_MODEL), jnp.float32)
    w_ada = jax.random.normal(ks[2], (DEPTH, D_MODEL, 3 * D_MODEL), jnp.float32) * (0.5 * D_MODEL ** -0.5)
    b_ada = 0.02 * jax.random.normal(ks[3], (DEPTH, 3 * D_MODEL), jnp.float32)
    col_scale = []
    for idx, w in enumerate(IN_SPLITS):
        is_value = idx in (2, 6)
        col_scale.append(jnp.full((w,), DEEPNORM_BETA if is_value else 1.0, jnp.float32))
    col_scale = jnp.concatenate(col_scale)
    w_in = jax.random.normal(ks[4], (DEPTH, D_MODEL, IN_WIDTH), jnp.float32) * (D_MODEL ** -0.5) * col_scale
    b_f = 2.0 + 0.5 * jax.random.normal(ks[5], (DEPTH, FOX_HEADS), jnp.float32)
    w_out = jax.random.normal(ks[6], (DEPTH, MIX_WIDTH, D_MODEL), jnp.float32) * (MIX_WIDTH ** -0.5) * DEEPNORM_BETA
    ln_g = 1.0 + 0.02 * jax.random.normal(ks[7], (DEPTH, D_MODEL), jnp.float32)
    ln_b = 0.02 * jax.random.normal(ks[8], (DEPTH, D_MODEL), jnp.float32)
    return {"x": x, "c": c, "w_ada": w_ada, "b_ada": b_ada, "w_in": w_in, "b_f": b_f,
            "w_out": w_out, "ln_g": ln_g, "ln_b": ln_b}


def reference(x, c, w_ada, b_ada, w_in, b_f, w_out, ln_g, ln_b):
    dtype = x.dtype
    seq = x.shape[1]
    n_blocks = seq // Q_BLOCK
    pos = jnp.arange(seq, dtype=jnp.int32)
    for layer in range(DEPTH):
        mod = jax.nn.silu(c) @ w_ada[layer] + b_ada[layer]
        shift = mod[:, :D_MODEL]
        scale = mod[:, D_MODEL:2 * D_MODEL]
        gate = mod[:, 2 * D_MODEL:]
        u = (_layer_norm(x) * (1.0 + scale[:, None, :].astype(jnp.float32))
             + shift[:, None, :].astype(jnp.float32)).astype(dtype)

        h = u @ w_in[layer]
        fq, fk, fv, fg, ff, sq, sk, sv, sg = _split_columns(h)

        log_f = jax.nn.log_sigmoid(ff.astype(jnp.float32) + b_f[layer].astype(jnp.float32))
        f_cum = jnp.cumsum(log_f, axis=1).transpose(0, 2, 1)

        fq, fk, fv = _to_heads(fq, FOX_HEADS), _to_heads(fk, FOX_HEADS), _to_heads(fv, FOX_HEADS)
        sq, sk, sv = _to_heads(sq, SB_HEADS), _to_heads(sk, SB_HEADS), _to_heads(sv, SB_HEADS)

        fox_out, sb_out = [], []
        for i in range(n_blocks):
            qs, ke = i * Q_BLOCK, (i + 1) * Q_BLOCK
            q_pos, k_pos = pos[qs:ke], pos[:ke]
            fox_out.append(_fox_block(fq[:, :, qs:ke], fk[:, :, :ke], fv[:, :, :ke],
                                      f_cum[:, :, qs:ke], f_cum[:, :, :ke], q_pos, k_pos))
            sb_out.append(_stick_breaking_block(sq[:, :, qs:ke], sk[:, :, :ke], sv[:, :, :ke],
                                                q_pos, k_pos))
        y_fox = _from_heads(jnp.concatenate(fox_out, axis=2)) * jax.nn.silu(fg)
        y_sb = _from_heads(jnp.concatenate(sb_out, axis=2)) * jax.nn.silu(sg)
        y = jnp.concatenate([y_fox, y_sb], axis=-1) @ w_out[layer]

        resid = DEEPNORM_ALPHA * x.astype(jnp.float32) + gate[:, None, :].astype(jnp.float32) * y.astype(jnp.float32)
        x = _layer_norm(resid, ln_g[layer], ln_b[layer]).astype(dtype)
    return x
```

```cpp
#include <hip/hip_runtime.h>
#include <hip/hip_cooperative_groups.h>
#include <cstdio>
#include <cstdint>
namespace cg = cooperative_groups;
namespace pg8 {
#define PG8_LAS __attribute__((address_space(3)))
typedef unsigned short bf16_t;
typedef short bf16x8 __attribute__((ext_vector_type(8)));
typedef float f32x4 __attribute__((ext_vector_type(4)));
typedef unsigned u32x4 __attribute__((ext_vector_type(4)));
constexpr int BM = 256, BK = 64, HALF = 128, HTB = HALF * BK * 2  , STAGE_BYTES = 8 * HTB, NXCD = 8, WGM = 8;

__host__ __device__ __forceinline__ int lds_byte(int r, int c) { const int st = (r >> 4) * 2 + (c >> 5), rr = r & 15, cc = c & 31, ob = rr * 64 + cc * 2; return st * 1024 + (ob ^ (((ob >> 9) & 1) << 5)); }
__host__ __device__ __forceinline__ void stage_rc(int b, int& R, int& C) { const int st = b / 1024, sb = b % 1024, swz = sb ^ (((sb >> 9) & 1) << 5); R = (st >> 1) * 16 + swz / 64; C = (st & 1) * 32 + (swz % 64) / 2; }
__host__ __device__ __forceinline__ int perm32(int rho) { const int n = rho >> 4, i = rho & 15; return 8 * (i >> 2) + 4 * n + (i & 3); }

struct Unit { int pm, pn; };
struct Gemm { const bf16_t* A; const bf16_t* Bt; int M, N, K; };

struct StaticOrder {
    int nM, nN, nwg, G, c;
    __host__ __device__ void init(int M, int N, int G_, int c_) { nM = M / BM; nN = N / BM; nwg = nM * nN; G = G_; c = c_; }
    __host__ __device__ bool next(int i, Unit& u) const {
        const long L = (long)i * G + c; if (L >= nwg) return false;
        int wgid = (int)L; { const int q = nwg / NXCD, r = nwg % NXCD, xcd = wgid % NXCD, off = wgid / NXCD; wgid = (xcd < r ? xcd * (q + 1) : r * (q + 1) + (xcd - r) * q) + off; }
        const int nig = WGM * nN, gid = wgid / nig, fm = gid * WGM, gsz = (nM - fm) < WGM ? (nM - fm) : WGM;
        u.pm = fm + ((wgid % nig) % gsz); u.pn = (wgid % nig) / gsz; return true;
    }
    __device__ __forceinline__ void a_ready(const Unit&) const {}
    __device__ __forceinline__ void done(const Unit&) const {}
};

__device__ __forceinline__ unsigned cvt_pk_bf16(float lo, float hi) { unsigned r; asm volatile("v_cvt_pk_bf16_f32 %0, %1, %2" : "=v"(r) : "v"(lo), "v"(hi)); return r; }
typedef float f32x2 __attribute__((ext_vector_type(2)));
__device__ __forceinline__ f32x2 gelu_pk(f32x2 v) {
    const f32x2 av = __builtin_elementwise_abs(v), d = av * 0.2316418882f + 1.0f;
    f32x2 t; t.x = __builtin_amdgcn_rcpf(d.x); t.y = __builtin_amdgcn_rcpf(d.y);
    f32x2 q = t * 0.5307027145f + (-0.7265760135f); q = q * t + 0.7107068705f; q = q * t + (-0.142248368f); q = q * t + 0.127414796f; q = q * t;
    const f32x2 s = (v * v) * (-0.72134752044f);
    f32x2 e; e.x = __builtin_amdgcn_exp2f(s.x); e.y = __builtin_amdgcn_exp2f(s.y);
    const f32x2 m = v * (q * e), r = v - m;
    f32x2 o; o.x = v.x < 0.f ? m.x : r.x; o.y = v.y < 0.f ? m.y : r.y; return o;
}

template <int ACT  > struct EpiBf16 {
    static constexpr bool PERM = true, AFTER_DRAIN = false; static_assert(ACT == 0 || ACT == 1, "EpiBf16: ACT is 0 (none) or 1 (gelu_pk)");
    bf16_t* O; int ldc; const float* bias; int split_cols; size_t split_stride; float scale0;
    __device__ __forceinline__ void operator()(const f32x4 (&acc)[2][2][4][2], const Unit& u, int wr, int wc, int fr, int fq) const {
        const int row0 = u.pm * BM + wr * 64 + fr; int colt = u.pn * BM; bf16_t* base = O;
        float sc = 1.f; if (split_cols) { const int t = colt / split_cols; base += (size_t)t * split_stride; colt -= t * split_cols; if (t == 0) sc = scale0; }
        const int col0 = colt + wc * 32 + 8 * fq, bcol0 = u.pn * BM + wc * 32 + 8 * fq;
        f32x4 bv[2][2];
#pragma unroll
        for (int bj = 0; bj < 2; ++bj)
#pragma unroll
            for (int n = 0; n < 2; ++n) bv[bj][n] = bias ? *(const f32x4*)(bias + bcol0 + bj * HALF + 4 * n) : (f32x4){0.f, 0.f, 0.f, 0.f};
#pragma unroll
        for (int ai = 0; ai < 2; ++ai)
#pragma unroll
            for (int m = 0; m < 4; ++m) { bf16_t* rowp = base + (size_t)(row0 + ai * HALF + m * 16) * ldc + col0;
#pragma unroll
                for (int bj = 0; bj < 2; ++bj) { f32x4 v0 = acc[ai][bj][m][0] + bv[bj][0], v1 = acc[ai][bj][m][1] + bv[bj][1];
                    if (ACT == 1) { f32x2 a = gelu_pk((f32x2){v0[0], v0[1]}), b = gelu_pk((f32x2){v0[2], v0[3]}), c = gelu_pk((f32x2){v1[0], v1[1]}), d = gelu_pk((f32x2){v1[2], v1[3]});
                        v0 = (f32x4){a.x, a.y, b.x, b.y}; v1 = (f32x4){c.x, c.y, d.x, d.y}; }
                    v0 = v0 * sc; v1 = v1 * sc; u32x4 w; w.x = cvt_pk_bf16(v0[0], v0[1]); w.y = cvt_pk_bf16(v0[2], v0[3]); w.z = cvt_pk_bf16(v1[0], v1[1]); w.w = cvt_pk_bf16(v1[2], v1[3]);
                    *(u32x4*)(rowp + bj * HALF) = w; } }
    }
};

template <class Epi, class Sched, bool ALIGN_EPI = false, bool SP2 = false>
__device__ __forceinline__ void gemm_phase(PG8_LAS unsigned char* lds, const Gemm g, const Sched& S, const Epi& E) {
    const int tid = threadIdx.x, wid = __builtin_amdgcn_readfirstlane(tid >> 6), lane = tid & 63, wr = wid >> 2, wc = wid & 3, fr = lane & 15, fq = lane >> 4;
    const int K = g.K, nt = K / BK;
    unsigned voffA[2], voffB[2];
#pragma unroll
    for (int i = 0; i < 2; ++i) { int R, C; stage_rc(tid * 16 + i * 8192, R, C); const int Rb = Epi::PERM ? ((R & ~31) + perm32(R & 31)) : R;
        voffA[i] = (unsigned)(R * K + C) * 2u; voffB[i] = (unsigned)(Rb * K + C) * 2u; }
    const size_t kstep = (size_t)(BK * 2);
    const size_t hstep = (size_t)HALF * K * 2;
    const size_t tstep = 2 * hstep;
    const unsigned ldsw = (unsigned)wid * 1024u;
    const int aoff = lds_byte(wr * 64 + fr, fq * 8), boff = lds_byte(wc * 32 + fr, fq * 8);
#define PG8_SA(b, h) (((b) * 2 + (h)) * HTB)
#define PG8_SB(b, h) ((4 + (b) * 2 + (h)) * HTB)
#define PG8_STAGE(bufoff, gbase, voff) do { _Pragma("unroll") for (int _i = 0; _i < 2; ++_i) \
        __builtin_amdgcn_global_load_lds((const unsigned*)((const char*)(gbase) + (voff)[_i]), (PG8_LAS unsigned*)(lds + (bufoff) + ldsw + _i * 8192), 16, 0, 0); } while (0)
#define PG8_LDA(dst, b, h) do { _Pragma("unroll") for (int m = 0; m < 4; ++m) _Pragma("unroll") for (int k = 0; k < 2; ++k) dst[m][k] = *(const PG8_LAS bf16x8*)(lds + PG8_SA(b, h) + aoff + m * 2048 + k * 1024); } while (0)
#define PG8_LDB(dst, b, h) do { _Pragma("unroll") for (int n = 0; n < 2; ++n) _Pragma("unroll") for (int k = 0; k < 2; ++k) dst[n][k] = *(const PG8_LAS bf16x8*)(lds + PG8_SB(b, h) + boff + n * 2048 + k * 1024); } while (0)
#define PG8_MMA(ai, bj, At, Bt) do { __builtin_amdgcn_s_setprio(1); _Pragma("unroll") for (int m = 0; m < 4; ++m) _Pragma("unroll") for (int n = 0; n < 2; ++n) _Pragma("unroll") for (int k = 0; k < 2; ++k) \
        acc[ai][bj][m][n] = __builtin_amdgcn_mfma_f32_16x16x32_bf16(Bt[n][k], At[m][k], acc[ai][bj][m][n], 0, 0, 0); __builtin_amdgcn_s_setprio(0); } while (0)
#define PG8_WAIT_V(n) asm volatile("s_waitcnt vmcnt(" #n ")" ::: "memory")
#define PG8_WAIT_L(n) asm volatile("s_waitcnt lgkmcnt(" #n ")" ::: "memory")
#define PG8_BAR __builtin_amdgcn_s_barrier()
#define PG8_SCHED __builtin_amdgcn_sched_barrier(0)
    Unit cur, nxt; int ui = 0;
    if (!S.next(0, cur)) return;
    f32x4 acc[2][2][4][2];
#pragma unroll
    for (int a = 0; a < 2; ++a)
#pragma unroll
        for (int b = 0; b < 2; ++b)
#pragma unroll
            for (int m = 0; m < 4; ++m)
#pragma unroll
                for (int n = 0; n < 2; ++n) acc[a][b][m][n] = (f32x4){0.f, 0.f, 0.f, 0.f};
    bf16x8 At[4][2], B0[2][2], B1[2][2];
    const char* cA = (const char*)g.A + (size_t)cur.pm * tstep; const char* cB = (const char*)g.Bt + (size_t)cur.pn * tstep;
    S.a_ready(cur);
    if constexpr (SP2) {
        PG8_STAGE(PG8_SB(0, 0), cB, voffB); PG8_STAGE(PG8_SB(0, 1), cB + hstep, voffB); PG8_STAGE(PG8_SA(0, 0), cA, voffA); PG8_STAGE(PG8_SA(0, 1), cA + hstep, voffA);
        if (wr == 1) PG8_BAR;
        PG8_WAIT_V(2); PG8_BAR;
        PG8_STAGE(PG8_SB(1, 0), cB + kstep, voffB); PG8_STAGE(PG8_SA(1, 0), cA + kstep, voffA); PG8_STAGE(PG8_SB(1, 1), cB + hstep + kstep, voffB);
        PG8_WAIT_V(6); PG8_BAR;
    } else {
        PG8_STAGE(PG8_SB(0, 0), cB, voffB); PG8_STAGE(PG8_SA(0, 0), cA, voffA); PG8_STAGE(PG8_SB(0, 1), cB + hstep, voffB); PG8_STAGE(PG8_SA(0, 1), cA + hstep, voffA);
        if (wr == 1) PG8_BAR;
        PG8_WAIT_V(4); PG8_BAR;
        PG8_STAGE(PG8_SB(1, 0), cB + kstep, voffB); PG8_STAGE(PG8_SA(1, 0), cA + kstep, voffA); PG8_STAGE(PG8_SB(1, 1), cB + hstep + kstep, voffB);
        PG8_WAIT_V(6); PG8_BAR;
    }
    for (;;) {
        const bool has_next = S.next(ui + 1, nxt);
        const char* nA = has_next ? (const char*)g.A + (size_t)nxt.pm * tstep : cA; const char* nB = has_next ? (const char*)g.Bt + (size_t)nxt.pn * tstep : cB;
        for (int t = 0; t < nt; t += 2) {
            const bool last = (t == nt - 2);
            const char* a1 = cA + (size_t)(t + 1) * kstep;
            const char* a2 = last ? nA : cA + (size_t)(t + 2) * kstep; const char* b2 = last ? nB : cB + (size_t)(t + 2) * kstep;
            const char* a3 = a2 + kstep; const char* b3 = b2 + kstep;
            if (last && has_next) S.a_ready(nxt);
            if constexpr (SP2) {
            PG8_LDB(B0, 0, 0); PG8_LDB(B1, 0, 1); PG8_SCHED; PG8_LDA(At, 0, 0); PG8_STAGE(PG8_SA(1, 1), a1 + hstep, voffA);
            PG8_WAIT_V(8); PG8_WAIT_L(0); PG8_BAR; PG8_MMA(0, 0, At, B0); PG8_MMA(0, 1, At, B1); PG8_BAR; PG8_SCHED;
            PG8_LDA(At, 0, 1); PG8_STAGE(PG8_SB(0, 0), b2, voffB); PG8_STAGE(PG8_SB(0, 1), b2 + hstep, voffB); PG8_STAGE(PG8_SA(0, 0), a2, voffA);
            PG8_WAIT_V(8); PG8_WAIT_L(0); PG8_BAR; PG8_MMA(1, 0, At, B0); PG8_MMA(1, 1, At, B1); PG8_BAR; PG8_SCHED;
            PG8_LDB(B0, 1, 0); PG8_LDB(B1, 1, 1); PG8_SCHED; PG8_LDA(At, 1, 0); PG8_STAGE(PG8_SA(0, 1), a2 + hstep, voffA);
            PG8_WAIT_V(8); PG8_WAIT_L(0); PG8_BAR; PG8_MMA(0, 0, At, B0); PG8_MMA(0, 1, At, B1); PG8_BAR; PG8_SCHED;
            PG8_LDA(At, 1, 1); PG8_STAGE(PG8_SB(1, 0), b3, voffB); PG8_STAGE(PG8_SB(1, 1), b3 + hstep, voffB); PG8_STAGE(PG8_SA(1, 0), a3, voffA);
            PG8_WAIT_V(8); PG8_WAIT_L(0); PG8_BAR; PG8_MMA(1, 0, At, B0); PG8_MMA(1, 1, At, B1); PG8_BAR; PG8_SCHED;
            } else {
            PG8_LDB(B0, 0, 0); PG8_SCHED; PG8_LDA(At, 0, 0); PG8_STAGE(PG8_SA(1, 1), a1 + hstep, voffA);
            PG8_WAIT_L(8); PG8_BAR; PG8_WAIT_L(0); PG8_MMA(0, 0, At, B0); PG8_BAR; PG8_SCHED;
            PG8_LDB(B1, 0, 1); PG8_STAGE(PG8_SB(0, 0), b2, voffB);
            PG8_BAR; PG8_WAIT_L(0); PG8_MMA(0, 1, At, B1); PG8_BAR;
            PG8_LDA(At, 0, 1); PG8_STAGE(PG8_SA(0, 0), a2, voffA);
            PG8_BAR; PG8_WAIT_L(0); PG8_MMA(1, 0, At, B0); PG8_BAR; PG8_SCHED;
            PG8_STAGE(PG8_SB(0, 1), b2 + hstep, voffB);
            PG8_WAIT_V(6); PG8_BAR; PG8_MMA(1, 1, At, B1); PG8_BAR;
            PG8_LDB(B0, 1, 0); PG8_SCHED; PG8_LDA(At, 1, 0); PG8_STAGE(PG8_SA(0, 1), a2 + hstep, voffA);
            PG8_WAIT_L(8); PG8_BAR; PG8_WAIT_L(0); PG8_MMA(0, 0, At, B0); PG8_BAR; PG8_SCHED;
            PG8_LDB(B1, 1, 1); PG8_STAGE(PG8_SB(1, 0), b3, voffB);
            PG8_BAR; PG8_WAIT_L(0); PG8_MMA(0, 1, At, B1); PG8_BAR;
            PG8_LDA(At, 1, 1); PG8_STAGE(PG8_SA(1, 0), a3, voffA);
            PG8_BAR; PG8_WAIT_L(0); PG8_MMA(1, 0, At, B0); PG8_BAR; PG8_SCHED;
            PG8_STAGE(PG8_SB(1, 1), b3 + hstep, voffB);
            PG8_WAIT_V(6); PG8_BAR; PG8_MMA(1, 1, At, B1); PG8_BAR;
            }
        }
        if constexpr (ALIGN_EPI) { if (wr == 0) PG8_BAR; }
        if constexpr (!Epi::AFTER_DRAIN) { E(acc, cur, wr, wc, fr, fq); S.done(cur); }
        if (!has_next) break;
#pragma unroll
        for (int a = 0; a < 2; ++a)
#pragma unroll
            for (int b = 0; b < 2; ++b)
#pragma unroll
                for (int m = 0; m < 4; ++m)
#pragma unroll
                    for (int n = 0; n < 2; ++n) acc[a][b][m][n] = (f32x4){0.f, 0.f, 0.f, 0.f};
        cur = nxt; cA = nA; cB = nB; ++ui;
        if constexpr (ALIGN_EPI) { if (wr == 1) PG8_BAR; }
    }
    PG8_WAIT_V(0);
    if constexpr (!ALIGN_EPI) { if (wr == 0) PG8_BAR; }
    PG8_BAR;
    if constexpr (Epi::AFTER_DRAIN) { E.fused(acc, cur, wr, wc, fr, fq, lds, wid, lane); S.done(cur); }
#undef PG8_SA
#undef PG8_SB
#undef PG8_STAGE
#undef PG8_LDA
#undef PG8_LDB
#undef PG8_MMA
#undef PG8_WAIT_V
#undef PG8_WAIT_L
#undef PG8_BAR
#undef PG8_SCHED
}
}

constexpr int SEQ = 8192, DMODEL = 1024, MROWS = 16384, HP = 4096, INW = 4104;
constexpr float LOG2E = 1.4426950408889634f;
constexpr float C2 = 0.125f * LOG2E;
constexpr float DN_ALPHA = 1.189207115002721f;
constexpr float LN_EPS = 1e-5f;
constexpr size_t MiB = 1u << 20;
constexpr size_t WS_CTL = 0, WS_WTIN = 1 * MiB, WS_WTOUT = 9 * MiB, WS_MOD = 11 * MiB, WS_LF = 12 * MiB, WS_F = 13 * MiB, WS_U = 16 * MiB, WS_H = 48 * MiB, WS_Y = 176 * MiB, WS_END = 208 * MiB;
constexpr int CW_CTR = 0, CW_KMAX = 64;
constexpr int LDS_BYTES = 147456;
#ifndef N_LAUNCHES
#define N_LAUNCHES 1
#endif

#define LAS __attribute__((address_space(3)))
typedef unsigned short bf16;
typedef short bf16x8 __attribute__((ext_vector_type(8)));
typedef short s16x4 __attribute__((ext_vector_type(4)));
typedef float f32x4 __attribute__((ext_vector_type(4)));
typedef float f32x16 __attribute__((ext_vector_type(16)));
typedef unsigned u32x4 __attribute__((ext_vector_type(4)));
typedef unsigned u32x2 __attribute__((ext_vector_type(2)));

__device__ __forceinline__ unsigned pk2(float lo, float hi) {
    typedef float f2_t __attribute__((ext_vector_type(2))); typedef __bf16 b2_t __attribute__((ext_vector_type(2)));
    f2_t v = {lo, hi}; b2_t b = __builtin_convertvector(v, b2_t); return __builtin_bit_cast(unsigned, b);
}
__device__ __forceinline__ float bf2f(unsigned short u) { return __uint_as_float(((unsigned)u) << 16); }
__device__ __forceinline__ float wave_sum(float v) {
#pragma unroll
    for (int o = 1; o < 64; o <<= 1) v += __shfl_xor(v, o);
    return v;
}
__device__ __forceinline__ float silu_f(float v) { return v / (1.f + __expf(-v)); }

struct EpiH {
    static constexpr bool PERM = true, AFTER_DRAIN = false;
    bf16* O; unsigned* kmax;
    __device__ __forceinline__ void operator()(const pg8::f32x4 (&acc)[2][2][4][2], const pg8::Unit& u, int wr, int wc, int fr, int fq) const {
        const int row0 = u.pm * 256 + wr * 64 + fr, col0 = u.pn * 256 + wc * 32 + 8 * fq;
        const bool isK = (u.pn == 2 || u.pn == 3);
        float mx[2] = {0.f, 0.f};
#pragma unroll
        for (int ai = 0; ai < 2; ++ai)
#pragma unroll
            for (int m = 0; m < 4; ++m) { bf16* rowp = O + (size_t)(row0 + ai * 128 + m * 16) * HP + col0;
#pragma unroll
                for (int bj = 0; bj < 2; ++bj) { const pg8::f32x4 v0 = acc[ai][bj][m][0], v1 = acc[ai][bj][m][1];
                    u32x4 w; w.x = pk2(v0[0], v0[1]); w.y = pk2(v0[2], v0[3]); w.z = pk2(v1[0], v1[1]); w.w = pk2(v1[2], v1[3]);
                    *(u32x4*)(rowp + bj * 128) = w;
                    if (isK) { float ss = (v0[0] * v0[0] + v0[1] * v0[1]) + (v0[2] * v0[2] + v0[3] * v0[3]) + (v1[0] * v1[0] + v1[1] * v1[1]) + (v1[2] * v1[2] + v1[3] * v1[3]);
                        ss += __shfl_xor(ss, 16); ss += __shfl_xor(ss, 32); mx[bj] = fmaxf(mx[bj], ss); } } }
        if (isK) {
#pragma unroll
            for (int bj = 0; bj < 2; ++bj) { float v = mx[bj];
#pragma unroll
                for (int o = 1; o < 16; o <<= 1) v = fmaxf(v, __shfl_xor(v, o));
                const int head = (u.pn * 256 + bj * 128 + wc * 32 - 512) >> 6, b = (u.pm >= 32) ? 1 : 0;
                if ((threadIdx.x & 63) == 0) atomicMax(kmax + ((b * 8 + head) * 2 + (wc & 1)), __float_as_uint(v)); }
        }
    }
};
struct EpiResid {
    static constexpr bool PERM = false, AFTER_DRAIN = false;
    const float* x; const float* mod; float* out;
    __device__ __forceinline__ void operator()(const pg8::f32x4 (&acc)[2][2][4][2], const pg8::Unit& u, int wr, int wc, int fr, int fq) const {
        const int b = (u.pm >= 32) ? 1 : 0; const int col0 = u.pn * 256 + wc * 32 + 4 * fq;
#pragma unroll
        for (int bj = 0; bj < 2; ++bj)
#pragma unroll
            for (int n = 0; n < 2; ++n) { const int col = col0 + bj * 128 + n * 16; const pg8::f32x4 g = *(const pg8::f32x4*)(mod + b * 3072 + 2048 + col);
#pragma unroll
                for (int ai = 0; ai < 2; ++ai)
#pragma unroll
                    for (int m = 0; m < 4; ++m) { const size_t off = (size_t)(u.pm * 256 + ai * 128 + wr * 64 + m * 16 + fr) * DMODEL + col;
                        const pg8::f32x4 xv = *(const pg8::f32x4*)(x + off); *(pg8::f32x4*)(out + off) = xv * DN_ALPHA + g * acc[ai][bj][m][n]; } }
    }
};

namespace att {
constexpr int L_K = 0, L_V = 16384, L_FK = 32768, L_FLAG = 33280, L_UNIT = 33408, L_WSF = 33536, L_STG = 36864;
__device__ __forceinline__ int crow(int r, int hi) { return (r & 3) + 8 * (r >> 2) + 4 * hi; }
typedef short v4i16_t __attribute__((ext_vector_type(4)));
__device__ __forceinline__ s16x4 vtr(const LAS unsigned char* p) { return __builtin_bit_cast(s16x4, __builtin_amdgcn_ds_read_tr16_b64_v4i16((LAS v4i16_t*)p)); }
#define MFMA32(a, b, c) __builtin_amdgcn_mfma_f32_32x32x16_bf16((a), (b), (c), 0, 0, 0)

template <bool FOX>
__device__ __forceinline__ void unit(const bf16* __restrict__ H, const float* __restrict__ F, const unsigned* __restrict__ kmaxw, bf16* __restrict__ Y, int b, int h, int qb, LAS unsigned char* lds) {
    const int tid = threadIdx.x, lane = tid & 63, r32 = lane & 31, hi = lane >> 5;
    const int wid = __builtin_amdgcn_readfirstlane(tid >> 6);
    const int q0 = qb * 256, qw0 = q0 + 32 * wid;
    const size_t rowbase = (size_t)b * SEQ;
    const int colQ = (FOX ? 0 : 2048) + h * 64, colK = colQ + 512, colV = colQ + 1024, colG = colQ + 1536;
    const int bh = b * 8 + h;
    LAS float* wsf = (LAS float*)(lds + L_WSF + wid * 256);
    bf16x8 qr[4];
    { const bf16* qp = H + (rowbase + qw0 + r32) * HP + colQ + hi * 8;
#pragma unroll
        for (int d0 = 0; d0 < 4; ++d0) qr[d0] = *(const bf16x8*)(qp + d0 * 16); }
    float Fq = 0.f, qk = 0.f, m = -1e30f, l = 0.f, carry = 0.f;
    if (FOX) {
        Fq = F[(size_t)bh * SEQ + qw0 + r32];
        float ss = 0.f;
#pragma unroll
        for (int d0 = 0; d0 < 4; ++d0)
#pragma unroll
            for (int e = 0; e < 8; ++e) { const float v = bf2f((unsigned short)qr[d0][e]); ss += v * v; }
        ss += __shfl_xor(ss, 32);
        const float km = sqrtf(__uint_as_float(kmaxw[bh * 2]) + __uint_as_float(kmaxw[bh * 2 + 1]));
        qk = sqrtf(ss) * km * 1.02f + 1.0f;
    }
    f32x16 o0, o1;
#pragma unroll
    for (int r = 0; r < 16; ++r) { o0[r] = 0.f; o1[r] = 0.f; }
    bf16x8 tp0, tp1;
#pragma unroll
    for (int s = 0; s < 8; ++s) { const int kvl = 4 * hi + (s & 3) + 8 * (s >> 2); tp0[s] = (kvl > r32) ? (short)0x3F80 : (short)0; tp1[s] = (16 + kvl > r32) ? (short)0x3F80 : (short)0; }
    const int tmax = 4 * qb + 3, td = qw0 >> 6, qoff = qw0 & 63;
    const bf16* ksrc = H + (rowbase + lane) * HP + colK + wid * 8;
    const bf16* vsrc = H + (rowbase + (tid >> 3)) * HP + colV + (tid & 7) * 8;
    const float* fsrc = F + (size_t)bh * SEQ + (tid & 63);
    const int kdst = L_K + wid * 1024 + lane * 16;
    const int vdst = L_V + ((tid & 7) >> 2) * 4096 + (tid >> 3) * 64 + (tid & 3) * 16;
    u32x4 kreg, vreg; float freg = 0.f;
    { const size_t off = (size_t)tmax * 64 * HP;
        kreg = *(const u32x4*)(ksrc + off); vreg = *(const u32x4*)(vsrc + off); if (FOX && tid < 64) freg = fsrc[tmax * 64];
        *(LAS u32x4*)(lds + kdst) = kreg; *(LAS u32x4*)(lds + vdst) = vreg; if (FOX && tid < 64) ((LAS float*)(lds + L_FK))[tid] = freg; }
    __syncthreads();
    bool done = false;
    int it = 0;
    for (int t = tmax; t >= 0; --t, ++it) {
        const int buf = it & 1;
        if (t > 0) { const size_t off = (size_t)(t - 1) * 64 * HP; kreg = *(const u32x4*)(ksrc + off); vreg = *(const u32x4*)(vsrc + off); if (FOX && tid < 64) freg = fsrc[(t - 1) * 64]; }
        if (!done && t <= td) {
            const LAS unsigned char* Kb = lds + L_K + buf * 8192; const LAS unsigned char* Vb = lds + L_V + buf * 8192;
            f32x16 p0, p1;
            if (FOX) {
                const LAS float* fkp = (const LAS float*)(lds + L_FK + buf * 256) + 4 * hi;
#pragma unroll
                for (int g = 0; g < 4; ++g) { const f32x4 a = *(const LAS f32x4*)(fkp + 8 * g), c = *(const LAS f32x4*)(fkp + 32 + 8 * g);
#pragma unroll
                    for (int e = 0; e < 4; ++e) { p0[4 * g + e] = Fq - a[e]; p1[4 * g + e] = Fq - c[e]; } }
            } else {
#pragma unroll
                for (int r = 0; r < 16; ++r) { p0[r] = 0.f; p1[r] = 0.f; }
            }
            { const LAS unsigned char* kb = Kb + hi * 1024 + r32 * 16;
#pragma unroll
                for (int d0 = 0; d0 < 4; ++d0) { const bf16x8 a0 = *(const LAS bf16x8*)(kb + d0 * 2048), a1 = *(const LAS bf16x8*)(kb + d0 * 2048 + 512);
                    p0 = MFMA32(a0, qr[d0], p0); p1 = MFMA32(a1, qr[d0], p1); } }
            if (FOX) {
                if (t == td) {
#pragma unroll
                    for (int r = 0; r < 16; ++r) { const int kv = crow(r, hi); if (kv > qoff + r32) p0[r] = -INFINITY; if (kv + 32 > qoff + r32) p1[r] = -INFINITY; }
                }
                float rm = fmaxf(p0[0], p1[0]);
#pragma unroll
                for (int r = 1; r < 16; ++r) rm = fmaxf(rm, fmaxf(p0[r], p1[r]));
                rm = fmaxf(rm, __shfl_xor(rm, 32));
                const float mn = fmaxf(m, rm);
                if (__any(mn > m)) {
                    const float al = exp2f(m - mn); l *= al;
                    if (hi == 0) wsf[r32] = al;
#pragma unroll
                    for (int r = 0; r < 16; ++r) { const float a = wsf[crow(r, hi)]; o0[r] *= a; o1[r] *= a; }
                }
                m = mn;
                float rs = 0.f;
#pragma unroll
                for (int r = 0; r < 16; ++r) { p0[r] = exp2f(p0[r] - m); p1[r] = exp2f(p1[r] - m); rs += p0[r] + p1[r]; }
                l += rs;
                const float fk0 = *(const LAS float*)(lds + L_FK + buf * 256);
                done = __all((qk + Fq - fk0 - m) < -151.f);
            } else {
                f32x16 lb0, lb1;
#pragma unroll
                for (int r = 0; r < 16; ++r) {
                    { const float z = p0[r], e = exp2f(-fabsf(z)), sp = fmaxf(z, 0.f) + __log2f(1.f + e); p0[r] = -sp; lb0[r] = z - sp; }
                    { const float z = p1[r], e = exp2f(-fabsf(z)), sp = fmaxf(z, 0.f) + __log2f(1.f + e); p1[r] = -sp; lb1[r] = z - sp; }
                }
                if (t == td) {
#pragma unroll
                    for (int r = 0; r < 16; ++r) { const int kv = crow(r, hi); if (kv >= qoff + r32) { p0[r] = 0.f; lb0[r] = -INFINITY; } if (kv + 32 >= qoff + r32) { p1[r] = 0.f; lb1[r] = -INFINITY; } }
                }
                float s0 = 0.f, s1 = 0.f;
#pragma unroll
                for (int r = 0; r < 16; ++r) { s0 += p0[r]; s1 += p1[r]; }
                s0 += __shfl_xor(s0, 32); s1 += __shfl_xor(s1, 32);
                u32x4 bh_[4], bl_[4];
#pragma unroll
                for (int ks = 0; ks < 4; ++ks)
#pragma unroll
                    for (int j = 0; j < 4; ++j) { const int r = 8 * (ks & 1) + 2 * j; const float a = (ks < 2) ? p0[r] : p1[r], c = (ks < 2) ? p0[r + 1] : p1[r + 1];
                        const unsigned hp = pk2(a, c); bh_[ks][j] = hp; bl_[ks][j] = pk2(a - __uint_as_float(hp << 16), c - __uint_as_float(hp & 0xffff0000u)); }
                f32x16 L0, L1; const float c0 = carry + s1;
#pragma unroll
                for (int r = 0; r < 16; ++r) { L0[r] = c0; L1[r] = carry; }
                L0 = MFMA32(tp0, __builtin_bit_cast(bf16x8, bh_[0]), L0); L0 = MFMA32(tp1, __builtin_bit_cast(bf16x8, bh_[1]), L0);
                L1 = MFMA32(tp0, __builtin_bit_cast(bf16x8, bh_[2]), L1); L1 = MFMA32(tp1, __builtin_bit_cast(bf16x8, bh_[3]), L1);
                L0 = MFMA32(tp0, __builtin_bit_cast(bf16x8, bl_[0]), L0); L0 = MFMA32(tp1, __builtin_bit_cast(bf16x8, bl_[1]), L0);
                L1 = MFMA32(tp0, __builtin_bit_cast(bf16x8, bl_[2]), L1); L1 = MFMA32(tp1, __builtin_bit_cast(bf16x8, bl_[3]), L1);
#pragma unroll
                for (int r = 0; r < 16; ++r) { p0[r] = exp2f(lb0[r] + L0[r]); p1[r] = exp2f(lb1[r] + L1[r]); }
                carry += s0 + s1;
                done = __all(carry < -150.f);
            }
            u32x4 pa[4];
#pragma unroll
            for (int j = 0; j < 4; ++j) { pa[0][j] = pk2(p0[2 * j], p0[2 * j + 1]); pa[1][j] = pk2(p0[8 + 2 * j], p0[9 + 2 * j]); pa[2][j] = pk2(p1[2 * j], p1[2 * j + 1]); pa[3][j] = pk2(p1[8 + 2 * j], p1[9 + 2 * j]); }
            const LAS unsigned char* vp = Vb + ((lane >> 4) & 1) * 32 + (lane & 3) * 8 + (4 * hi + ((lane & 15) >> 2)) * 64;
#pragma unroll
            for (int ks = 0; ks < 4; ++ks) {
                const s16x4 a0 = vtr(vp + ks * 1024), a1 = vtr(vp + ks * 1024 + 512), c0 = vtr(vp + 4096 + ks * 1024), c1 = vtr(vp + 4096 + ks * 1024 + 512);
                const bf16x8 v0 = (bf16x8){a0[0], a0[1], a0[2], a0[3], a1[0], a1[1], a1[2], a1[3]}, v1 = (bf16x8){c0[0], c0[1], c0[2], c0[3], c1[0], c1[1], c1[2], c1[3]};
                o0 = MFMA32(__builtin_bit_cast(bf16x8, pa[ks]), v0, o0); o1 = MFMA32(__builtin_bit_cast(bf16x8, pa[ks]), v1, o1);
            }
        }
        if (lane == 0) ((LAS unsigned*)(lds + L_FLAG))[buf * 8 + wid] = done ? 1u : 0u;
        if (t > 0) { const int nb = (buf ^ 1) * 8192;
            *(LAS u32x4*)(lds + kdst + nb) = kreg; *(LAS u32x4*)(lds + vdst + nb) = vreg; if (FOX && tid < 64) ((LAS float*)(lds + L_FK + (buf ^ 1) * 256))[tid] = freg; }
        __syncthreads();
        const u32x4 f0 = *(const LAS u32x4*)(lds + L_FLAG + buf * 32), f1 = *(const LAS u32x4*)(lds + L_FLAG + buf * 32 + 16);
        if ((f0.x & f0.y & f0.z & f0.w & f1.x & f1.y & f1.z & f1.w) != 0u) break;
    }
    if (FOX) {
        l += __shfl_xor(l, 32);
        if (hi == 0) wsf[r32] = 1.f / l;
#pragma unroll
        for (int r = 0; r < 16; ++r) { const float a = wsf[crow(r, hi)]; o0[r] *= a; o1[r] *= a; }
    }
    LAS float* stg = (LAS float*)(lds + L_STG + wid * 8192);
#pragma unroll
    for (int r = 0; r < 16; ++r) { const int orow = crow(r, hi); stg[orow * 64 + r32] = o0[r]; stg[orow * 64 + 32 + r32] = o1[r]; }
#pragma unroll
    for (int i = 0; i < 4; ++i) { const int row = i * 8 + (lane >> 3), ch = lane & 7;
        const f32x4 a = *(const LAS f32x4*)(stg + row * 64 + ch * 8), c = *(const LAS f32x4*)(stg + row * 64 + ch * 8 + 4);
        const u32x4 g = *(const u32x4*)(H + (rowbase + qw0 + row) * HP + colG + ch * 8);
        u32x4 w;
        w.x = pk2(a[0] * silu_f(__uint_as_float(g.x << 16)), a[1] * silu_f(__uint_as_float(g.x & 0xffff0000u)));
        w.y = pk2(a[2] * silu_f(__uint_as_float(g.y << 16)), a[3] * silu_f(__uint_as_float(g.y & 0xffff0000u)));
        w.z = pk2(c[0] * silu_f(__uint_as_float(g.z << 16)), c[1] * silu_f(__uint_as_float(g.z & 0xffff0000u)));
        w.w = pk2(c[2] * silu_f(__uint_as_float(g.w << 16)), c[3] * silu_f(__uint_as_float(g.w & 0xffff0000u)));
        *(u32x4*)(Y + (rowbase + qw0 + row) * DMODEL + (FOX ? 0 : 512) + h * 64 + ch * 8) = w; }
}
}

struct KArgs { const float* x; const float* c; const float* w_ada; const float* b_ada; const float* w_in; const float* b_f; const float* w_out; const float* ln_g; const float* ln_b; float* out; unsigned char* ws; int ph_lo; int ph_hi; };

__device__ __forceinline__ void transpose_item(const float* __restrict__ W, int ldw, int srccol0, int k0, bf16* __restrict__ WT, int K, int dstrow0, float scale, LAS float* scr, int lane) {
#pragma unroll 8
    for (int i = 0; i < 32; ++i) { const int kk = 2 * i + (lane >> 5); scr[kk * 33 + (lane & 31)] = W[(size_t)(k0 + kk) * ldw + srccol0 + (lane & 31)]; }
    asm volatile("s_waitcnt lgkmcnt(0)" ::: "memory");
    const int c = lane & 7;
#pragma unroll
    for (int j = 0; j < 4; ++j) { const int n = (lane >> 3) + 8 * j; const LAS float* s = scr + (8 * c) * 33 + n;
        u32x4 o; o.x = pk2(s[0] * scale, s[33] * scale); o.y = pk2(s[66] * scale, s[99] * scale); o.z = pk2(s[132] * scale, s[165] * scale); o.w = pk2(s[198] * scale, s[231] * scale);
        *(u32x4*)(WT + (size_t)(dstrow0 + n) * K + k0 + 8 * c) = o; }
    asm volatile("s_waitcnt lgkmcnt(0)" ::: "memory");
}

__global__ void __launch_bounds__(512) fwd_kernel(KArgs a) {
    extern __shared__ __attribute__((aligned(16))) unsigned char lds_raw[];
    LAS unsigned char* lds = (LAS unsigned char*)lds_raw;
    cg::grid_group grid = cg::this_grid();
    const int tid = threadIdx.x, lane = tid & 63, wid = __builtin_amdgcn_readfirstlane(tid >> 6);
    const int blk = blockIdx.x, G = gridDim.x;
    unsigned char* ws = a.ws;
    unsigned* ctl = (unsigned*)(ws + WS_CTL);
    bf16* WTin = (bf16*)(ws + WS_WTIN); bf16* WTout = (bf16*)(ws + WS_WTOUT);
    float* modv = (float*)(ws + WS_MOD); float* LF = (float*)(ws + WS_LF); float* Fc = (float*)(ws + WS_F);
    bf16* U = (bf16*)(ws + WS_U); bf16* Hb = (bf16*)(ws + WS_H); bf16* Yb = (bf16*)(ws + WS_Y);
    const int lo = a.ph_lo, hi_ = a.ph_hi;
#define IN(k) (lo <= (k) && (k) < hi_)
#define BOTH(k) (IN(k) && IN((k) + 1))

    if (IN(0)) {
        if (blk == 0 && tid < 128) ctl[tid] = 0u;
        if (blk < 96) {
            LAS float* sc = (LAS float*)lds; LAS float* red = (LAS float*)(lds + 8192);
            for (int i = tid; i < 2048; i += 512) sc[i] = silu_f(a.c[i]);
            __syncthreads();
            const int n = tid & 31, kg = tid >> 5, col = 32 * blk + n;
            float a0 = 0.f, a1 = 0.f;
#pragma unroll 8
            for (int k = 64 * kg; k < 64 * kg + 64; ++k) { const float w = a.w_ada[(size_t)k * 3072 + col]; a0 += sc[k] * w; a1 += sc[1024 + k] * w; }
            red[(kg * 32 + n) * 2] = a0; red[(kg * 32 + n) * 2 + 1] = a1;
            __syncthreads();
            if (tid < 64) { const int nn = tid & 31, bb = tid >> 5; float s = a.b_ada[32 * blk + nn];
                for (int g = 0; g < 16; ++g) s += red[(g * 32 + nn) * 2 + bb];
                modv[bb * 3072 + 32 * blk + nn] = s; }
            __syncthreads();
        }
        LAS float* scr = (LAS float*)(lds + wid * 16384);
        const int gw = blk * 8 + wid, NGW = G * 8;
        for (int it = gw; it < 2048 + 512; it += NGW) {
            if (it < 2048) { const int nb = it & 127, kb = it >> 7, n0 = 32 * nb;
                const float scl = (n0 < 512 || (n0 >= 2048 && n0 < 2560)) ? C2 : 1.f;
                transpose_item(a.w_in, INW, n0 + (n0 >= 2048 ? 8 : 0), 64 * kb, WTin, 1024, n0, scl, scr, lane);
            } else { const int r = it - 2048, nb = r & 31, kb = r >> 5;
                transpose_item(a.w_out, 1024, 32 * nb, 64 * kb, WTout, 1024, 32 * nb, 1.f, scr, lane); }
        }
        __syncthreads();
    }
    if (BOTH(0)) grid.sync();

    if (IN(1)) {
        LAS float* wff = (LAS float*)lds;
        for (int i = tid; i < 2048; i += 512) { const int col = i >> 1, half = i & 1; const f32x4 v = *(const f32x4*)(a.w_in + (size_t)col * INW + 2048 + 4 * half);
            wff[(4 * half + 0) * 1024 + col] = v[0]; wff[(4 * half + 1) * 1024 + col] = v[1]; wff[(4 * half + 2) * 1024 + col] = v[2]; wff[(4 * half + 3) * 1024 + col] = v[3]; }
        __syncthreads();
        for (int rb = blk; rb < MROWS / 64; rb += G) {
            const int b = rb >> 7;
            f32x4 sc1[4], sh[4];
#pragma unroll
            for (int j = 0; j < 4; ++j) { sh[j] = *(const f32x4*)(modv + b * 3072 + 4 * (lane + 64 * j)); sc1[j] = *(const f32x4*)(modv + b * 3072 + 1024 + 4 * (lane + 64 * j)) + 1.f; }
            const float bfl = a.b_f[lane & 7];
            for (int i = 0; i < 8; ++i) {
                const int row = rb * 64 + wid * 8 + i;
                const f32x4* xr = (const f32x4*)(a.x + (size_t)row * DMODEL) + lane;
                f32x4 v[4]; float s = 0.f;
#pragma unroll
                for (int j = 0; j < 4; ++j) { v[j] = xr[64 * j]; s += (v[j][0] + v[j][1]) + (v[j][2] + v[j][3]); }
                const float mean = wave_sum(s) * (1.f / DMODEL); float s2 = 0.f;
#pragma unroll
                for (int j = 0; j < 4; ++j) { v[j] = v[j] - mean; s2 += (v[j][0] * v[j][0] + v[j][1] * v[j][1]) + (v[j][2] * v[j][2] + v[j][3] * v[j][3]); }
                const float rstd = 1.f / sqrtf(wave_sum(s2) * (1.f / DMODEL) + LN_EPS);
                u32x2* o8 = (u32x2*)(U + (size_t)row * DMODEL) + lane;
#pragma unroll
                for (int j = 0; j < 4; ++j) { v[j] = v[j] * rstd * sc1[j] + sh[j]; u32x2 w; w.x = pk2(v[j][0], v[j][1]); w.y = pk2(v[j][2], v[j][3]); o8[64 * j] = w; }
                float ffv = 0.f;
#pragma unroll
                for (int q = 0; q < 8; ++q) { float d = 0.f;
#pragma unroll
                    for (int j = 0; j < 4; ++j) { const f32x4 w = *(const LAS f32x4*)(wff + q * 1024 + 4 * (lane + 64 * j)); d += (v[j][0] * w[0] + v[j][1] * w[1]) + (v[j][2] * w[2] + v[j][3] * w[3]); }
                    d = wave_sum(d); if (lane == q) ffv = d; }
                if (lane < 8) { const float t = ffv + bfl; const float ls = fminf(t, 0.f) - log1pf(__expf(-fabsf(t))); LF[(size_t)(b * 8 + lane) * SEQ + (row & (SEQ - 1))] = ls * LOG2E; }
            }
        }
        __syncthreads();
    }
    if (BOTH(1)) grid.sync();

    if (IN(2)) {
        for (int sq = blk; sq < 16; sq += G) {
            const float* src = LF + (size_t)sq * SEQ + tid * 16; f32x4 v[4]; float run = 0.f;
#pragma unroll
            for (int j = 0; j < 4; ++j) { v[j] = *(const f32x4*)(src + 4 * j);
#pragma unroll
                for (int e = 0; e < 4; ++e) { run += v[j][e]; v[j][e] = run; } }
            float xs = run;
#pragma unroll
            for (int o = 1; o < 64; o <<= 1) { const float y = __shfl_up(xs, o); if (lane >= o) xs += y; }
            LAS float* wt = (LAS float*)lds;
            if (lane == 63) wt[wid] = xs;
            __syncthreads();
            float off = xs - run;
            for (int w = 0; w < wid; ++w) off += wt[w];
            float* dst = Fc + (size_t)sq * SEQ + tid * 16;
#pragma unroll
            for (int j = 0; j < 4; ++j) *(f32x4*)(dst + 4 * j) = v[j] + off;
            __syncthreads();
        }
        pg8::Gemm g{U, WTin, MROWS, HP, 1024}; pg8::StaticOrder S; S.init(MROWS, HP, G, blk);
        EpiH E{Hb, ctl + CW_KMAX};
        pg8::gemm_phase<EpiH, pg8::StaticOrder, true, true>(lds, g, S, E);
    }
    if (BOTH(2)) grid.sync();

    if (IN(3)) {
        for (;;) {
            if (tid == 0) *(LAS unsigned*)(lds + att::L_UNIT) = atomicAdd(ctl + CW_CTR, 1u);
            __syncthreads();
            const unsigned u = (unsigned)__builtin_amdgcn_readfirstlane(*(const LAS unsigned*)(lds + att::L_UNIT));
            if (u >= 1024u) break;
            const int v = (int)(u & 511u), qb = 31 - (v >> 4), bh = v & 15;
            if (u < 512u) att::unit<true>(Hb, Fc, ctl + CW_KMAX, Yb, bh >> 3, bh & 7, qb, lds);
            else att::unit<false>(Hb, Fc, ctl + CW_KMAX, Yb, bh >> 3, bh & 7, qb, lds);
            __syncthreads();
        }
    }
    if (BOTH(3)) grid.sync();

    if (IN(4)) {
        pg8::Gemm g{Yb, WTout, MROWS, DMODEL, 1024}; pg8::StaticOrder S; S.init(MROWS, DMODEL, G, blk);
        EpiResid E{a.x, modv, a.out};
        pg8::gemm_phase<EpiResid, pg8::StaticOrder, true, true>(lds, g, S, E);
    }
    if (BOTH(4)) grid.sync();

    if (IN(5)) {
        f32x4 gv[4], bv[4];
#pragma unroll
        for (int j = 0; j < 4; ++j) { gv[j] = *(const f32x4*)(a.ln_g + 4 * (lane + 64 * j)); bv[j] = *(const f32x4*)(a.ln_b + 4 * (lane + 64 * j)); }
        for (int row = blk * 8 + wid; row < MROWS; row += G * 8) {
            f32x4* xr = (f32x4*)(a.out + (size_t)row * DMODEL) + lane;
            f32x4 v[4]; float s = 0.f;
#pragma unroll
            for (int j = 0; j < 4; ++j) { v[j] = xr[64 * j]; s += (v[j][0] + v[j][1]) + (v[j][2] + v[j][3]); }
            const float mean = wave_sum(s) * (1.f / DMODEL); float s2 = 0.f;
#pragma unroll
            for (int j = 0; j < 4; ++j) { v[j] = v[j] - mean; s2 += (v[j][0] * v[j][0] + v[j][1] * v[j][1]) + (v[j][2] * v[j][2] + v[j][3] * v[j][3]); }
            const float rstd = 1.f / sqrtf(wave_sum(s2) * (1.f / DMODEL) + LN_EPS);
#pragma unroll
            for (int j = 0; j < 4; ++j) xr[64 * j] = v[j] * rstd * gv[j] + bv[j];
        }
    }
#undef IN
#undef BOTH
}

extern "C" void kernel_launch(void* const* d_in, const int* in_sizes, int n_in, void* d_out, int out_size, void* d_ws, size_t ws_size, hipStream_t stream) {
    static int grid = 0;
    if (grid == 0) {
        if (n_in != 9 || out_size != MROWS * DMODEL || ws_size < WS_END) { fprintf(stderr, "kernel_launch: unexpected shapes (n_in %d, out %d, ws %zu)\n", n_in, out_size, ws_size); grid = -1; return; }
        if (hipFuncSetAttribute((const void*)fwd_kernel, hipFuncAttributeMaxDynamicSharedMemorySize, LDS_BYTES) != hipSuccess) { fprintf(stderr, "kernel_launch: hipFuncSetAttribute failed\n"); grid = -1; return; }
        int dev = 0, cus = 0, per_cu = 0;
        (void)hipGetDevice(&dev); (void)hipDeviceGetAttribute(&cus, hipDeviceAttributeMultiprocessorCount, dev);
        if (hipOccupancyMaxActiveBlocksPerMultiprocessor(&per_cu, (const void*)fwd_kernel, 512, LDS_BYTES) != hipSuccess || per_cu < 1) { fprintf(stderr, "kernel_launch: occupancy query says %d blocks per CU\n", per_cu); per_cu = 1; }
        (void)hipGetLastError();
        grid = cus > 0 ? cus : 256;
    }
    if (grid < 0) return;
    KArgs a{};
    a.x = (const float*)d_in[0]; a.c = (const float*)d_in[1]; a.w_ada = (const float*)d_in[2]; a.b_ada = (const float*)d_in[3]; a.w_in = (const float*)d_in[4];
    a.b_f = (const float*)d_in[5]; a.w_out = (const float*)d_in[6]; a.ln_g = (const float*)d_in[7]; a.ln_b = (const float*)d_in[8];
    a.out = (float*)d_out; a.ws = (unsigned char*)d_ws;
#if N_LAUNCHES == 1
    a.ph_lo = 0; a.ph_hi = 6;
    void* args[] = {&a};
    const hipError_t e = hipLaunchCooperativeKernel((const void*)fwd_kernel, dim3(grid), dim3(512), args, LDS_BYTES, stream);
    if (e != hipSuccess) fprintf(stderr, "kernel_launch: cooperative launch failed: %s (grid %d)\n", hipGetErrorString(e), grid);
#else
    for (int p = 0; p < 6; ++p) { a.ph_lo = p; a.ph_hi = p + 1; hipLaunchKernelGGL(fwd_kernel, dim3(grid), dim3(512), LDS_BYTES, stream, a); }
#endif
}
```

```cpp
#include <hip/hip_runtime.h>
#include <hip/hip_cooperative_groups.h>
#include <cstdio>
#include <cstdint>
namespace cg = cooperative_groups;
namespace pg8 {
#define PG8_LAS __attribute__((address_space(3)))
typedef unsigned short bf16_t;
typedef short bf16x8 __attribute__((ext_vector_type(8)));
typedef float f32x4 __attribute__((ext_vector_type(4)));
typedef unsigned u32x4 __attribute__((ext_vector_type(4)));
constexpr int BM = 256, BK = 64, HALF = 128, HTB = HALF * BK * 2  , STAGE_BYTES = 8 * HTB, NXCD = 8, WGM = 8;

__host__ __device__ __forceinline__ int lds_byte(int r, int c) { const int st = (r >> 4) * 2 + (c >> 5), rr = r & 15, cc = c & 31, ob = rr * 64 + cc * 2; return st * 1024 + (ob ^ (((ob >> 9) & 1) << 5)); }
__host__ __device__ __forceinline__ void stage_rc(int b, int& R, int& C) { const int st = b / 1024, sb = b % 1024, swz = sb ^ (((sb >> 9) & 1) << 5); R = (st >> 1) * 16 + swz / 64; C = (st & 1) * 32 + (swz % 64) / 2; }
__host__ __device__ __forceinline__ int perm32(int rho) { const int n = rho >> 4, i = rho & 15; return 8 * (i >> 2) + 4 * n + (i & 3); }

struct Unit { int pm, pn; };
struct Gemm { const bf16_t* A; const bf16_t* Bt; int M, N, K; };

struct StaticOrder {
    int nM, nN, nwg, G, c;
    __host__ __device__ void init(int M, int N, int G_, int c_) { nM = M / BM; nN = N / BM; nwg = nM * nN; G = G_; c = c_; }
    __host__ __device__ bool next(int i, Unit& u) const {
        const long L = (long)i * G + c; if (L >= nwg) return false;
        int wgid = (int)L; { const int q = nwg / NXCD, r = nwg % NXCD, xcd = wgid % NXCD, off = wgid / NXCD; wgid = (xcd < r ? xcd * (q + 1) : r * (q + 1) + (xcd - r) * q) + off; }
        const int nig = WGM * nN, gid = wgid / nig, fm = gid * WGM, gsz = (nM - fm) < WGM ? (nM - fm) : WGM;
        u.pm = fm + ((wgid % nig) % gsz); u.pn = (wgid % nig) / gsz; return true;
    }
    __device__ __forceinline__ void a_ready(const Unit&) const {}
    __device__ __forceinline__ void done(const Unit&) const {}
};

__device__ __forceinline__ unsigned cvt_pk_bf16(float lo, float hi) { unsigned r; asm volatile("v_cvt_pk_bf16_f32 %0, %1, %2" : "=v"(r) : "v"(lo), "v"(hi)); return r; }
typedef float f32x2 __attribute__((ext_vector_type(2)));
__device__ __forceinline__ f32x2 gelu_pk(f32x2 v) {
    const f32x2 av = __builtin_elementwise_abs(v), d = av * 0.2316418882f + 1.0f;
    f32x2 t; t.x = __builtin_amdgcn_rcpf(d.x); t.y = __builtin_amdgcn_rcpf(d.y);
    f32x2 q = t * 0.5307027145f + (-0.7265760135f); q = q * t + 0.7107068705f; q = q * t + (-0.142248368f); q = q * t + 0.127414796f; q = q * t;
    const f32x2 s = (v * v) * (-0.72134752044f);
    f32x2 e; e.x = __builtin_amdgcn_exp2f(s.x); e.y = __builtin_amdgcn_exp2f(s.y);
    const f32x2 m = v * (q * e), r = v - m;
    f32x2 o; o.x = v.x < 0.f ? m.x : r.x; o.y = v.y < 0.f ? m.y : r.y; return o;
}

template <int ACT  > struct EpiBf16 {
    static constexpr bool PERM = true, AFTER_DRAIN = false; static_assert(ACT == 0 || ACT == 1, "EpiBf16: ACT is 0 (none) or 1 (gelu_pk)");
    bf16_t* O; int ldc; const float* bias; int split_cols; size_t split_stride; float scale0;
    __device__ __forceinline__ void operator()(const f32x4 (&acc)[2][2][4][2], const Unit& u, int wr, int wc, int fr, int fq) const {
        const int row0 = u.pm * BM + wr * 64 + fr; int colt = u.pn * BM; bf16_t* base = O;
        float sc = 1.f; if (split_cols) { const int t = colt / split_cols; base += (size_t)t * split_stride; colt -= t * split_cols; if (t == 0) sc = scale0; }
        const int col0 = colt + wc * 32 + 8 * fq, bcol0 = u.pn * BM + wc * 32 + 8 * fq;
        f32x4 bv[2][2];
#pragma unroll
        for (int bj = 0; bj < 2; ++bj)
#pragma unroll
            for (int n = 0; n < 2; ++n) bv[bj][n] = bias ? *(const f32x4*)(bias + bcol0 + bj * HALF + 4 * n) : (f32x4){0.f, 0.f, 0.f, 0.f};
#pragma unroll
        for (int ai = 0; ai < 2; ++ai)
#pragma unroll
            for (int m = 0; m < 4; ++m) { bf16_t* rowp = base + (size_t)(row0 + ai * HALF + m * 16) * ldc + col0;
#pragma unroll
                for (int bj = 0; bj < 2; ++bj) { f32x4 v0 = acc[ai][bj][m][0] + bv[bj][0], v1 = acc[ai][bj][m][1] + bv[bj][1];
                    if (ACT == 1) { f32x2 a = gelu_pk((f32x2){v0[0], v0[1]}), b = gelu_pk((f32x2){v0[2], v0[3]}), c = gelu_pk((f32x2){v1[0], v1[1]}), d = gelu_pk((f32x2){v1[2], v1[3]});
                        v0 = (f32x4){a.x, a.y, b.x, b.y}; v1 = (f32x4){c.x, c.y, d.x, d.y}; }
                    v0 = v0 * sc; v1 = v1 * sc; u32x4 w; w.x = cvt_pk_bf16(v0[0], v0[1]); w.y = cvt_pk_bf16(v0[2], v0[3]); w.z = cvt_pk_bf16(v1[0], v1[1]); w.w = cvt_pk_bf16(v1[2], v1[3]);
                    *(u32x4*)(rowp + bj * HALF) = w; } }
    }
};

template <class Epi, class Sched, bool ALIGN_EPI = false, bool SP2 = false>
__device__ __forceinline__ void gemm_phase(PG8_LAS unsigned char* lds, const Gemm g, const Sched& S, const Epi& E) {
    const int tid = threadIdx.x, wid = __builtin_amdgcn_readfirstlane(tid >> 6), lane = tid & 63, wr = wid >> 2, wc = wid & 3, fr = lane & 15, fq = lane >> 4;
    const int K = g.K, nt = K / BK;
    unsigned voffA[2], voffB[2];
#pragma unroll
    for (int i = 0; i < 2; ++i) { int R, C; stage_rc(tid * 16 + i * 8192, R, C); const int Rb = Epi::PERM ? ((R & ~31) + perm32(R & 31)) : R;
        voffA[i] = (unsigned)(R * K + C) * 2u; voffB[i] = (unsigned)(Rb * K + C) * 2u; }
    const size_t kstep = (size_t)(BK * 2);
    const size_t hstep = (size_t)HALF * K * 2;
    const size_t tstep = 2 * hstep;
    const unsigned ldsw = (unsigned)wid * 1024u;
    const int aoff = lds_byte(wr * 64 + fr, fq * 8), boff = lds_byte(wc * 32 + fr, fq * 8);
#define PG8_SA(b, h) (((b) * 2 + (h)) * HTB)
#define PG8_SB(b, h) ((4 + (b) * 2 + (h)) * HTB)
#define PG8_STAGE(bufoff, gbase, voff) do { _Pragma("unroll") for (int _i = 0; _i < 2; ++_i) \
        __builtin_amdgcn_global_load_lds((const unsigned*)((const char*)(gbase) + (voff)[_i]), (PG8_LAS unsigned*)(lds + (bufoff) + ldsw + _i * 8192), 16, 0, 0); } while (0)
#define PG8_LDA(dst, b, h) do { _Pragma("unroll") for (int m = 0; m < 4; ++m) _Pragma("unroll") for (int k = 0; k < 2; ++k) dst[m][k] = *(const PG8_LAS bf16x8*)(lds + PG8_SA(b, h) + aoff + m * 2048 + k * 1024); } while (0)
#define PG8_LDB(dst, b, h) do { _Pragma("unroll") for (int n = 0; n < 2; ++n) _Pragma("unroll") for (int k = 0; k < 2; ++k) dst[n][k] = *(const PG8_LAS bf16x8*)(lds + PG8_SB(b, h) + boff + n * 2048 + k * 1024); } while (0)
#define PG8_MMA(ai, bj, At, Bt) do { __builtin_amdgcn_s_setprio(1); _Pragma("unroll") for (int m = 0; m < 4; ++m) _Pragma("unroll") for (int n = 0; n < 2; ++n) _Pragma("unroll") for (int k = 0; k < 2; ++k) \
        acc[ai][bj][m][n] = __builtin_amdgcn_mfma_f32_16x16x32_bf16(Bt[n][k], At[m][k], acc[ai][bj][m][n], 0, 0, 0); __builtin_amdgcn_s_setprio(0); } while (0)
#define PG8_WAIT_V(n) asm volatile("s_waitcnt vmcnt(" #n ")" ::: "memory")
#define PG8_WAIT_L(n) asm volatile("s_waitcnt lgkmcnt(" #n ")" ::: "memory")
#define PG8_BAR __builtin_amdgcn_s_barrier()
#define PG8_SCHED __builtin_amdgcn_sched_barrier(0)
    Unit cur, nxt; int ui = 0;
    if (!S.next(0, cur)) return;
    f32x4 acc[2][2][4][2];
#pragma unroll
    for (int a = 0; a < 2; ++a)
#pragma unroll
        for (int b = 0; b < 2; ++b)
#pragma unroll
            for (int m = 0; m < 4; ++m)
#pragma unroll
                for (int n = 0; n < 2; ++n) acc[a][b][m][n] = (f32x4){0.f, 0.f, 0.f, 0.f};
    bf16x8 At[4][2], B0[2][2], B1[2][2];
    const char* cA = (const char*)g.A + (size_t)cur.pm * tstep; const char* cB = (const char*)g.Bt + (size_t)cur.pn * tstep;
    S.a_ready(cur);
    if constexpr (SP2) {
        PG8_STAGE(PG8_SB(0, 0), cB, voffB); PG8_STAGE(PG8_SB(0, 1), cB + hstep, voffB); PG8_STAGE(PG8_SA(0, 0), cA, voffA); PG8_STAGE(PG8_SA(0, 1), cA + hstep, voffA);
        if (wr == 1) PG8_BAR;
        PG8_WAIT_V(2); PG8_BAR;
        PG8_STAGE(PG8_SB(1, 0), cB + kstep, voffB); PG8_STAGE(PG8_SA(1, 0), cA + kstep, voffA); PG8_STAGE(PG8_SB(1, 1), cB + hstep + kstep, voffB);
        PG8_WAIT_V(6); PG8_BAR;
    } else {
        PG8_STAGE(PG8_SB(0, 0), cB, voffB); PG8_STAGE(PG8_SA(0, 0), cA, voffA); PG8_STAGE(PG8_SB(0, 1), cB + hstep, voffB); PG8_STAGE(PG8_SA(0, 1), cA + hstep, voffA);
        if (wr == 1) PG8_BAR;
        PG8_WAIT_V(4); PG8_BAR;
        PG8_STAGE(PG8_SB(1, 0), cB + kstep, voffB); PG8_STAGE(PG8_SA(1, 0), cA + kstep, voffA); PG8_STAGE(PG8_SB(1, 1), cB + hstep + kstep, voffB);
        PG8_WAIT_V(6); PG8_BAR;
    }
    for (;;) {
        const bool has_next = S.next(ui + 1, nxt);
        const char* nA = has_next ? (const char*)g.A + (size_t)nxt.pm * tstep : cA; const char* nB = has_next ? (const char*)g.Bt + (size_t)nxt.pn * tstep : cB;
        for (int t = 0; t < nt; t += 2) {
            const bool last = (t == nt - 2);
            const char* a1 = cA + (size_t)(t + 1) * kstep;
            const char* a2 = last ? nA : cA + (size_t)(t + 2) * kstep; const char* b2 = last ? nB : cB + (size_t)(t + 2) * kstep;
            const char* a3 = a2 + kstep; const char* b3 = b2 + kstep;
            if (last && has_next) S.a_ready(nxt);
            if constexpr (SP2) {
            PG8_LDB(B0, 0, 0); PG8_LDB(B1, 0, 1); PG8_SCHED; PG8_LDA(At, 0, 0); PG8_STAGE(PG8_SA(1, 1), a1 + hstep, voffA);
            PG8_WAIT_V(8); PG8_WAIT_L(0); PG8_BAR; PG8_MMA(0, 0, At, B0); PG8_MMA(0, 1, At, B1); PG8_BAR; PG8_SCHED;
            PG8_LDA(At, 0, 1); PG8_STAGE(PG8_SB(0, 0), b2, voffB); PG8_STAGE(PG8_SB(0, 1), b2 + hstep, voffB); PG8_STAGE(PG8_SA(0, 0), a2, voffA);
            PG8_WAIT_V(8); PG8_WAIT_L(0); PG8_BAR; PG8_MMA(1, 0, At, B0); PG8_MMA(1, 1, At, B1); PG8_BAR; PG8_SCHED;
            PG8_LDB(B0, 1, 0); PG8_LDB(B1, 1, 1); PG8_SCHED; PG8_LDA(At, 1, 0); PG8_STAGE(PG8_SA(0, 1), a2 + hstep, voffA);
            PG8_WAIT_V(8); PG8_WAIT_L(0); PG8_BAR; PG8_MMA(0, 0, At, B0); PG8_MMA(0, 1, At, B1); PG8_BAR; PG8_SCHED;
            PG8_LDA(At, 1, 1); PG8_STAGE(PG8_SB(1, 0), b3, voffB); PG8_STAGE(PG8_SB(1, 1), b3 + hstep, voffB); PG8_STAGE(PG8_SA(1, 0), a3, voffA);
            PG8_WAIT_V(8); PG8_WAIT_L(0); PG8_BAR; PG8_MMA(1, 0, At, B0); PG8_MMA(1, 1, At, B1); PG8_BAR; PG8_SCHED;
            } else {
            PG8_LDB(B0, 0, 0); PG8_SCHED; PG8_LDA(At, 0, 0); PG8_STAGE(PG8_SA(1, 1), a1 + hstep, voffA);
            PG8_WAIT_L(8); PG8_BAR; PG8_WAIT_L(0); PG8_MMA(0, 0, At, B0); PG8_BAR; PG8_SCHED;
            PG8_LDB(B1, 0, 1); PG8_STAGE(PG8_SB(0, 0), b2, voffB);
            PG8_BAR; PG8_WAIT_L(0); PG8_MMA(0, 1, At, B1); PG8_BAR;
            PG8_LDA(At, 0, 1); PG8_STAGE(PG8_SA(0, 0), a2, voffA);
            PG8_BAR; PG8_WAIT_L(0); PG8_MMA(1, 0, At, B0); PG8_BAR; PG8_SCHED;
            PG8_STAGE(PG8_SB(0, 1), b2 + hstep, voffB);
            PG8_WAIT_V(6); PG8_BAR; PG8_MMA(1, 1, At, B1); PG8_BAR;
            PG8_LDB(B0, 1, 0); PG8_SCHED; PG8_LDA(At, 1, 0); PG8_STAGE(PG8_SA(0, 1), a2 + hstep, voffA);
            PG8_WAIT_L(8); PG8_BAR; PG8_WAIT_L(0); PG8_MMA(0, 0, At, B0); PG8_BAR; PG8_SCHED;
            PG8_LDB(B1, 1, 1); PG8_STAGE(PG8_SB(1, 0), b3, voffB);
            PG8_BAR; PG8_WAIT_L(0); PG8_MMA(0, 1, At, B1); PG8_BAR;
            PG8_LDA(At, 1, 1); PG8_STAGE(PG8_SA(1, 0), a3, voffA);
            PG8_BAR; PG8_WAIT_L(0); PG8_MMA(1, 0, At, B0); PG8_BAR; PG8_SCHED;
            PG8_STAGE(PG8_SB(1, 1), b3 + hstep, voffB);
            PG8_WAIT_V(6); PG8_BAR; PG8_MMA(1, 1, At, B1); PG8_BAR;
            }
        }
        if constexpr (ALIGN_EPI) { if (wr == 0) PG8_BAR; }
        if constexpr (!Epi::AFTER_DRAIN) { E(acc, cur, wr, wc, fr, fq); S.done(cur); }
        if (!has_next) break;
#pragma unroll
        for (int a = 0; a < 2; ++a)
#pragma unroll
            for (int b = 0; b < 2; ++b)
#pragma unroll
                for (int m = 0; m < 4; ++m)
#pragma unroll
                    for (int n = 0; n < 2; ++n) acc[a][b][m][n] = (f32x4){0.f, 0.f, 0.f, 0.f};
        cur = nxt; cA = nA; cB = nB; ++ui;
        if constexpr (ALIGN_EPI) { if (wr == 1) PG8_BAR; }
    }
    PG8_WAIT_V(0);
    if constexpr (!ALIGN_EPI) { if (wr == 0) PG8_BAR; }
    PG8_BAR;
    if constexpr (Epi::AFTER_DRAIN) { E.fused(acc, cur, wr, wc, fr, fq, lds, wid, lane); S.done(cur); }
#undef PG8_SA
#undef PG8_SB
#undef PG8_STAGE
#undef PG8_LDA
#undef PG8_LDB
#undef PG8_MMA
#undef PG8_WAIT_V
#undef PG8_WAIT_L
#undef PG8_BAR
#undef PG8_SCHED
}
}

constexpr int SEQ = 8192, DMODEL = 1024, MROWS = 16384, HP = 4096, INW = 4104;
constexpr float LOG2E = 1.4426950408889634f;
constexpr float C2 = 0.125f * LOG2E;
constexpr float DN_ALPHA = 1.189207115002721f;
constexpr float LN_EPS = 1e-5f;
constexpr size_t MiB = 1u << 20;
constexpr size_t WS_CTL = 0, WS_WTIN = 1 * MiB, WS_WTOUT = 9 * MiB, WS_MOD = 11 * MiB, WS_LF = 12 * MiB, WS_F = 13 * MiB, WS_U = 16 * MiB, WS_H = 48 * MiB, WS_Y = 176 * MiB, WS_END = 208 * MiB;
constexpr int CW_CTR = 0, CW_KMAX = 64, CW_BAR = 4096, CW_WORDS = 8192;
constexpr int LDS_BYTES = 147456;
#ifndef N_LAUNCHES
#define N_LAUNCHES 1
#endif
#ifndef REPK
#define REPK -1
#endif
#define PHASE_REP(k) for (int rep = 0; rep < ((REPK == (k)) ? 2 : 1); ++rep)

#define LAS __attribute__((address_space(3)))
typedef unsigned short bf16;
typedef short bf16x8 __attribute__((ext_vector_type(8)));
typedef short s16x4 __attribute__((ext_vector_type(4)));
typedef float f32x4 __attribute__((ext_vector_type(4)));
typedef float f32x16 __attribute__((ext_vector_type(16)));
typedef unsigned u32x4 __attribute__((ext_vector_type(4)));
typedef unsigned u32x2 __attribute__((ext_vector_type(2)));

__device__ __forceinline__ unsigned pk2(float lo, float hi) {
    typedef float f2_t __attribute__((ext_vector_type(2))); typedef __bf16 b2_t __attribute__((ext_vector_type(2)));
    f2_t v = {lo, hi}; b2_t b = __builtin_convertvector(v, b2_t); return __builtin_bit_cast(unsigned, b);
}
__device__ __forceinline__ float bf2f(unsigned short u) { return __uint_as_float(((unsigned)u) << 16); }
__device__ __forceinline__ float wave_sum(float v) {
#pragma unroll
    for (int o = 1; o < 64; o <<= 1) v += __shfl_xor(v, o);
    return v;
}
__device__ __forceinline__ float silu_f(float v) { return v / (1.f + __expf(-v)); }

struct EpiH {
    static constexpr bool PERM = true, AFTER_DRAIN = false;
    bf16* O; unsigned* kmax;
    __device__ __forceinline__ void operator()(const pg8::f32x4 (&acc)[2][2][4][2], const pg8::Unit& u, int wr, int wc, int fr, int fq) const {
        const int row0 = u.pm * 256 + wr * 64 + fr, col0 = u.pn * 256 + wc * 32 + 8 * fq;
        const bool isK = (u.pn == 2 || u.pn == 3);
        float mx[2] = {0.f, 0.f};
#pragma unroll
        for (int ai = 0; ai < 2; ++ai)
#pragma unroll
            for (int m = 0; m < 4; ++m) { bf16* rowp = O + (size_t)(row0 + ai * 128 + m * 16) * HP + col0;
#pragma unroll
                for (int bj = 0; bj < 2; ++bj) { const pg8::f32x4 v0 = acc[ai][bj][m][0], v1 = acc[ai][bj][m][1];
                    u32x4 w; w.x = pk2(v0[0], v0[1]); w.y = pk2(v0[2], v0[3]); w.z = pk2(v1[0], v1[1]); w.w = pk2(v1[2], v1[3]);
                    *(u32x4*)(rowp + bj * 128) = w;
                    if (isK) { float ss = (v0[0] * v0[0] + v0[1] * v0[1]) + (v0[2] * v0[2] + v0[3] * v0[3]) + (v1[0] * v1[0] + v1[1] * v1[1]) + (v1[2] * v1[2] + v1[3] * v1[3]);
                        ss += __shfl_xor(ss, 16); ss += __shfl_xor(ss, 32); mx[bj] = fmaxf(mx[bj], ss); } } }
        if (isK) {
#pragma unroll
            for (int bj = 0; bj < 2; ++bj) { float v = mx[bj];
#pragma unroll
                for (int o = 1; o < 16; o <<= 1) v = fmaxf(v, __shfl_xor(v, o));
                const int head = (u.pn * 256 + bj * 128 + wc * 32 - 512) >> 6, b = (u.pm >= 32) ? 1 : 0;
                if ((threadIdx.x & 63) == 0) atomicMax(kmax + ((b * 8 + head) * 2 + (wc & 1)), __float_as_uint(v)); }
        }
    }
};
struct EpiResid {
    static constexpr bool PERM = false, AFTER_DRAIN = false;
    const float* x; const float* mod; float* out;
    __device__ __forceinline__ void operator()(const pg8::f32x4 (&acc)[2][2][4][2], const pg8::Unit& u, int wr, int wc, int fr, int fq) const {
        const int b = (u.pm >= 32) ? 1 : 0; const int col0 = u.pn * 256 + wc * 32 + 4 * fq;
#pragma unroll
        for (int bj = 0; bj < 2; ++bj)
#pragma unroll
            for (int n = 0; n < 2; ++n) { const int col = col0 + bj * 128 + n * 16; const pg8::f32x4 g = *(const pg8::f32x4*)(mod + b * 3072 + 2048 + col);
#pragma unroll
                for (int ai = 0; ai < 2; ++ai)
#pragma unroll
                    for (int m = 0; m < 4; ++m) { const size_t off = (size_t)(u.pm * 256 + ai * 128 + wr * 64 + m * 16 + fr) * DMODEL + col;
                        const pg8::f32x4 xv = *(const pg8::f32x4*)(x + off); *(pg8::f32x4*)(out + off) = xv * DN_ALPHA + g * acc[ai][bj][m][n]; } }
    }
};

struct StaticOrderRep {
    pg8::StaticOrder S; int rounds, reps;
    __device__ void init(int M, int N, int G, int c, int reps_) { S.init(M, N, G, c); rounds = (S.nwg + G - 1) / G; reps = reps_; }
    __device__ bool next(int i, pg8::Unit& u) const { if (i >= rounds * reps) return false; return S.next(i % rounds, u); }
    __device__ __forceinline__ void a_ready(const pg8::Unit&) const {}
    __device__ __forceinline__ void done(const pg8::Unit&) const {}
};
namespace att {
constexpr int L_K = 0, L_V = 16384, L_FK = 32768, L_FLAG = 33280, L_UNIT = 33408, L_WSF = 33536, L_STG = 36864;
__device__ __forceinline__ int crow(int r, int hi) { return (r & 3) + 8 * (r >> 2) + 4 * hi; }
typedef short v4i16_t __attribute__((ext_vector_type(4)));
__device__ __forceinline__ s16x4 vtr(const LAS unsigned char* p) { return __builtin_bit_cast(s16x4, __builtin_amdgcn_ds_read_tr16_b64_v4i16((LAS v4i16_t*)p)); }
#define MFMA32(a, b, c) __builtin_amdgcn_mfma_f32_32x32x16_bf16((a), (b), (c), 0, 0, 0)

template <bool FOX>
__device__ __forceinline__ void unit(const bf16* __restrict__ H, const float* __restrict__ F, const unsigned* __restrict__ kmaxw, bf16* __restrict__ Y, int b, int h, int qb, LAS unsigned char* lds) {
    const int tid = threadIdx.x, lane = tid & 63, r32 = lane & 31, hi = lane >> 5;
    const int wid = __builtin_amdgcn_readfirstlane(tid >> 6);
    const int q0 = qb * 256, qw0 = q0 + 32 * wid;
    const size_t rowbase = (size_t)b * SEQ;
    const int colQ = (FOX ? 0 : 2048) + h * 64, colK = colQ + 512, colV = colQ + 1024, colG = colQ + 1536;
    const int bh = b * 8 + h;
    LAS float* wsf = (LAS float*)(lds + L_WSF + wid * 256);
    bf16x8 qr[4];
    { const bf16* qp = H + (rowbase + qw0 + r32) * HP + colQ + hi * 8;
#pragma unroll
        for (int d0 = 0; d0 < 4; ++d0) qr[d0] = *(const bf16x8*)(qp + d0 * 16); }
    float Fq = 0.f, qk = 0.f, m = -1e30f, l = 0.f, carry = 0.f;
    if (FOX) {
        Fq = F[(size_t)bh * SEQ + qw0 + r32];
        float ss = 0.f;
#pragma unroll
        for (int d0 = 0; d0 < 4; ++d0)
#pragma unroll
            for (int e = 0; e < 8; ++e) { const float v = bf2f((unsigned short)qr[d0][e]); ss += v * v; }
        ss += __shfl_xor(ss, 32);
        const float km = sqrtf(__uint_as_float(kmaxw[bh * 2]) + __uint_as_float(kmaxw[bh * 2 + 1]));
        qk = sqrtf(ss) * km * 1.02f + 1.0f;
    }
    f32x16 o0, o1;
#pragma unroll
    for (int r = 0; r < 16; ++r) { o0[r] = 0.f; o1[r] = 0.f; }
    bf16x8 tp0, tp1;
#pragma unroll
    for (int s = 0; s < 8; ++s) { const int kvl = 4 * hi + (s & 3) + 8 * (s >> 2); tp0[s] = (kvl > r32) ? (short)0x3F80 : (short)0; tp1[s] = (16 + kvl > r32) ? (short)0x3F80 : (short)0; }
    const int tmax = 4 * qb + 3, td = qw0 >> 6, qoff = qw0 & 63;
    const bf16* ksrc = H + (rowbase + lane) * HP + colK + wid * 8;
    const bf16* vsrc = H + (rowbase + (tid >> 3)) * HP + colV + (tid & 7) * 8;
    const float* fsrc = F + (size_t)bh * SEQ + (tid & 63);
    const int kdst = L_K + wid * 1024 + lane * 16;
    const int vdst = L_V + ((tid & 7) >> 2) * 4096 + (tid >> 3) * 64 + (tid & 3) * 16;
    u32x4 kreg, vreg; float freg = 0.f;
    { const size_t off = (size_t)tmax * 64 * HP;
        kreg = *(const u32x4*)(ksrc + off); vreg = *(const u32x4*)(vsrc + off); if (FOX && tid < 64) freg = fsrc[tmax * 64];
        *(LAS u32x4*)(lds + kdst) = kreg; *(LAS u32x4*)(lds + vdst) = vreg; if (FOX && tid < 64) ((LAS float*)(lds + L_FK))[tid] = freg; }
    __syncthreads();
    bool done = false;
    int it = 0;
    for (int t = tmax; t >= 0; --t, ++it) {
        const int buf = it & 1;
        if (t > 0) { const size_t off = (size_t)(t - 1) * 64 * HP; kreg = *(const u32x4*)(ksrc + off); vreg = *(const u32x4*)(vsrc + off); if (FOX && tid < 64) freg = fsrc[(t - 1) * 64]; }
        if (!done && t <= td) {
            const LAS unsigned char* Kb = lds + L_K + buf * 8192; const LAS unsigned char* Vb = lds + L_V + buf * 8192;
            f32x16 p0, p1;
            if (FOX) {
                const LAS float* fkp = (const LAS float*)(lds + L_FK + buf * 256) + 4 * hi;
#pragma unroll
                for (int g = 0; g < 4; ++g) { const f32x4 a = *(const LAS f32x4*)(fkp + 8 * g), c = *(const LAS f32x4*)(fkp + 32 + 8 * g);
#pragma unroll
                    for (int e = 0; e < 4; ++e) { p0[4 * g + e] = Fq - a[e]; p1[4 * g + e] = Fq - c[e]; } }
            } else {
#pragma unroll
                for (int r = 0; r < 16; ++r) { p0[r] = 0.f; p1[r] = 0.f; }
            }
            { const LAS unsigned char* kb = Kb + hi * 1024 + r32 * 16;
#pragma unroll
                for (int d0 = 0; d0 < 4; ++d0) { const bf16x8 a0 = *(const LAS bf16x8*)(kb + d0 * 2048), a1 = *(const LAS bf16x8*)(kb + d0 * 2048 + 512);
                    p0 = MFMA32(a0, qr[d0], p0); p1 = MFMA32(a1, qr[d0], p1); } }
            if (FOX) {
                if (t == td) {
#pragma unroll
                    for (int r = 0; r < 16; ++r) { const int kv = crow(r, hi); if (kv > qoff + r32) p0[r] = -INFINITY; if (kv + 32 > qoff + r32) p1[r] = -INFINITY; }
                }
                float rm = fmaxf(p0[0], p1[0]);
#pragma unroll
                for (int r = 1; r < 16; ++r) rm = fmaxf(rm, fmaxf(p0[r], p1[r]));
                rm = fmaxf(rm, __shfl_xor(rm, 32));
                const float mn = fmaxf(m, rm);
                if (__any(mn > m)) {
                    const float al = exp2f(m - mn); l *= al;
                    if (hi == 0) wsf[r32] = al;
#pragma unroll
                    for (int r = 0; r < 16; ++r) { const float a = wsf[crow(r, hi)]; o0[r] *= a; o1[r] *= a; }
                }
                m = mn;
                float rs = 0.f;
#pragma unroll
                for (int r = 0; r < 16; ++r) { p0[r] = exp2f(p0[r] - m); p1[r] = exp2f(p1[r] - m); rs += p0[r] + p1[r]; }
                l += rs;
                const float fk0 = *(const LAS float*)(lds + L_FK + buf * 256);
                done = __all((qk + Fq - fk0 - m) < -151.f);
            } else {
                f32x16 lb0, lb1;
#pragma unroll
                for (int r = 0; r < 16; ++r) {
                    { const float z = p0[r], e = exp2f(-fabsf(z)), sp = fmaxf(z, 0.f) + __log2f(1.f + e); p0[r] = -sp; lb0[r] = z - sp; }
                    { const float z = p1[r], e = exp2f(-fabsf(z)), sp = fmaxf(z, 0.f) + __log2f(1.f + e); p1[r] = -sp; lb1[r] = z - sp; }
                }
                if (t == td) {
#pragma unroll
                    for (int r = 0; r < 16; ++r) { const int kv = crow(r, hi); if (kv >= qoff + r32) { p0[r] = 0.f; lb0[r] = -INFINITY; } if (kv + 32 >= qoff + r32) { p1[r] = 0.f; lb1[r] = -INFINITY; } }
                }
                float s0 = 0.f, s1 = 0.f;
#pragma unroll
                for (int r = 0; r < 16; ++r) { s0 += p0[r]; s1 += p1[r]; }
                s0 += __shfl_xor(s0, 32); s1 += __shfl_xor(s1, 32);
                u32x4 bh_[4], bl_[4];
#pragma unroll
                for (int ks = 0; ks < 4; ++ks)
#pragma unroll
                    for (int j = 0; j < 4; ++j) { const int r = 8 * (ks & 1) + 2 * j; const float a = (ks < 2) ? p0[r] : p1[r], c = (ks < 2) ? p0[r + 1] : p1[r + 1];
                        const unsigned hp = pk2(a, c); bh_[ks][j] = hp; bl_[ks][j] = pk2(a - __uint_as_float(hp << 16), c - __uint_as_float(hp & 0xffff0000u)); }
                f32x16 L0, L1; const float c0 = carry + s1;
#pragma unroll
                for (int r = 0; r < 16; ++r) { L0[r] = c0; L1[r] = carry; }
                L0 = MFMA32(tp0, __builtin_bit_cast(bf16x8, bh_[0]), L0); L0 = MFMA32(tp1, __builtin_bit_cast(bf16x8, bh_[1]), L0);
                L1 = MFMA32(tp0, __builtin_bit_cast(bf16x8, bh_[2]), L1); L1 = MFMA32(tp1, __builtin_bit_cast(bf16x8, bh_[3]), L1);
                L0 = MFMA32(tp0, __builtin_bit_cast(bf16x8, bl_[0]), L0); L0 = MFMA32(tp1, __builtin_bit_cast(bf16x8, bl_[1]), L0);
                L1 = MFMA32(tp0, __builtin_bit_cast(bf16x8, bl_[2]), L1); L1 = MFMA32(tp1, __builtin_bit_cast(bf16x8, bl_[3]), L1);
#pragma unroll
                for (int r = 0; r < 16; ++r) { p0[r] = exp2f(lb0[r] + L0[r]); p1[r] = exp2f(lb1[r] + L1[r]); }
                carry += s0 + s1;
                done = __all(carry < -150.f);
            }
            u32x4 pa[4];
#pragma unroll
            for (int j = 0; j < 4; ++j) { pa[0][j] = pk2(p0[2 * j], p0[2 * j + 1]); pa[1][j] = pk2(p0[8 + 2 * j], p0[9 + 2 * j]); pa[2][j] = pk2(p1[2 * j], p1[2 * j + 1]); pa[3][j] = pk2(p1[8 + 2 * j], p1[9 + 2 * j]); }
            const LAS unsigned char* vp = Vb + ((lane >> 4) & 1) * 32 + (lane & 3) * 8 + (4 * hi + ((lane & 15) >> 2)) * 64;
#pragma unroll
            for (int ks = 0; ks < 4; ++ks) {
                const s16x4 a0 = vtr(vp + ks * 1024), a1 = vtr(vp + ks * 1024 + 512), c0 = vtr(vp + 4096 + ks * 1024), c1 = vtr(vp + 4096 + ks * 1024 + 512);
                const bf16x8 v0 = (bf16x8){a0[0], a0[1], a0[2], a0[3], a1[0], a1[1], a1[2], a1[3]}, v1 = (bf16x8){c0[0], c0[1], c0[2], c0[3], c1[0], c1[1], c1[2], c1[3]};
                o0 = MFMA32(__builtin_bit_cast(bf16x8, pa[ks]), v0, o0); o1 = MFMA32(__builtin_bit_cast(bf16x8, pa[ks]), v1, o1);
            }
        }
        if (lane == 0) ((LAS unsigned*)(lds + L_FLAG))[buf * 8 + wid] = done ? 1u : 0u;
        if (t > 0) { const int nb = (buf ^ 1) * 8192;
            *(LAS u32x4*)(lds + kdst + nb) = kreg; *(LAS u32x4*)(lds + vdst + nb) = vreg; if (FOX && tid < 64) ((LAS float*)(lds + L_FK + (buf ^ 1) * 256))[tid] = freg; }
        __syncthreads();
        const u32x4 f0 = *(const LAS u32x4*)(lds + L_FLAG + buf * 32), f1 = *(const LAS u32x4*)(lds + L_FLAG + buf * 32 + 16);
        if ((f0.x & f0.y & f0.z & f0.w & f1.x & f1.y & f1.z & f1.w) != 0u) break;
    }
    if (FOX) {
        l += __shfl_xor(l, 32);
        if (hi == 0) wsf[r32] = 1.f / l;
#pragma unroll
        for (int r = 0; r < 16; ++r) { const float a = wsf[crow(r, hi)]; o0[r] *= a; o1[r] *= a; }
    }
    LAS float* stg = (LAS float*)(lds + L_STG + wid * 8192);
#pragma unroll
    for (int r = 0; r < 16; ++r) { const int orow = crow(r, hi); stg[orow * 64 + r32] = o0[r]; stg[orow * 64 + 32 + r32] = o1[r]; }
#pragma unroll
    for (int i = 0; i < 4; ++i) { const int row = i * 8 + (lane >> 3), ch = lane & 7;
        const f32x4 a = *(const LAS f32x4*)(stg + row * 64 + ch * 8), c = *(const LAS f32x4*)(stg + row * 64 + ch * 8 + 4);
        const u32x4 g = *(const u32x4*)(H + (rowbase + qw0 + row) * HP + colG + ch * 8);
        u32x4 w;
        w.x = pk2(a[0] * silu_f(__uint_as_float(g.x << 16)), a[1] * silu_f(__uint_as_float(g.x & 0xffff0000u)));
        w.y = pk2(a[2] * silu_f(__uint_as_float(g.y << 16)), a[3] * silu_f(__uint_as_float(g.y & 0xffff0000u)));
        w.z = pk2(c[0] * silu_f(__uint_as_float(g.z << 16)), c[1] * silu_f(__uint_as_float(g.z & 0xffff0000u)));
        w.w = pk2(c[2] * silu_f(__uint_as_float(g.w << 16)), c[3] * silu_f(__uint_as_float(g.w & 0xffff0000u)));
        *(u32x4*)(Y + (rowbase + qw0 + row) * DMODEL + (FOX ? 0 : 512) + h * 64 + ch * 8) = w; }
}
}

#define XB_TMO      128
#define XB_XCNT(j)  (256  + 64 * (j))
#define XB_XSUB(j)  (1280 + 64 * (j))
#define XB_XGEN(j)  (2304 + 64 * (j))
#define XB_TOP      3328
#define XB_TOPGEN   3392
#define XCD_BAR_WORDS 3456
#define XB_SPIN_CAP (1u << 18)

__device__ __forceinline__ unsigned xb_ld(unsigned* p)              { return __hip_atomic_load(p, __ATOMIC_RELAXED, __HIP_MEMORY_SCOPE_AGENT); }
__device__ __forceinline__ unsigned xb_add(unsigned* p, unsigned v) { return __hip_atomic_fetch_add(p, v, __ATOMIC_RELAXED, __HIP_MEMORY_SCOPE_AGENT); }
__device__ __forceinline__ unsigned xb_xcc_id() { return (unsigned)__builtin_amdgcn_s_getreg((3 << 11) | 20) & 0xFu; }
#define XB_SPIN(cond, bar) do { unsigned _sp = 0; while (cond) { __builtin_amdgcn_s_sleep(1); \
    if ((++_sp & 255u) == 0u) { if (xb_ld(&(bar)[XB_TMO])) break; if (_sp > XB_SPIN_CAP) { atomicAdd(&(bar)[XB_TMO], 1u); break; } } } } while (0)

struct XcdBarrier {
    unsigned* bar; unsigned x;
    volatile LAS unsigned* st;
};

__device__ __forceinline__ XcdBarrier xcd_barrier_post(unsigned* bar, volatile LAS unsigned* st) {
    XcdBarrier b; b.bar = bar; b.x = xb_xcc_id(); b.st = st;
    if (threadIdx.x == 0) (void)xb_add(&bar[XB_XCNT(b.x)], 1u);
    return b;
}
__device__ __forceinline__ void xcd_barrier_complete(unsigned* bar, unsigned x, unsigned& nloc, unsigned& nx) {
    const unsigned G = gridDim.x * gridDim.y * gridDim.z;
    unsigned sum, cnt, mine, sp = 0u;
    for (;;) {
        sum = 0u; cnt = 0u; mine = 0u;
#pragma unroll
        for (unsigned j = 0; j < 16; ++j) { const unsigned c = xb_ld(&bar[XB_XCNT(j)]); sum += c; cnt += (c > 0u) ? 1u : 0u; mine = (j == x) ? c : mine; }
        if (sum == G) break;
        __builtin_amdgcn_s_sleep(1);
        if ((++sp & 255u) == 0u) { if (xb_ld(&bar[XB_TMO])) break; if (sp > XB_SPIN_CAP) { atomicAdd(&bar[XB_TMO], 1u); break; } }
    }
    nloc = mine > 0u ? mine : 1u; nx = cnt > 0u ? cnt : 1u;
}

__device__ __forceinline__ void xcd_barrier(const XcdBarrier& b) {
    asm volatile("s_waitcnt vmcnt(0)" ::: "memory");
    __syncthreads();
    if (threadIdx.x == 0) {
        unsigned* bar = b.bar;
        __builtin_amdgcn_s_waitcnt(0);
        unsigned nloc = b.st[0], nx = b.st[1];
        if (nloc == 0u) { xcd_barrier_complete(bar, b.x, nloc, nx); b.st[0] = nloc; b.st[1] = nx; }
        const unsigned old = xb_add(&bar[XB_XSUB(b.x)], 1u);
        const unsigned gen = old / nloc;
        if (old + 1u == (gen + 1u) * nloc) {
            __builtin_amdgcn_fence(__ATOMIC_RELEASE, "agent");
            asm volatile("s_waitcnt vmcnt(0)" ::: "memory");
            const unsigned og = xb_add(&bar[XB_TOP], 1u);
            const unsigned tg = og / nx;
            if (og + 1u == (tg + 1u) * nx) xb_add(&bar[XB_TOPGEN], 1u);
            else XB_SPIN(xb_ld(&bar[XB_TOPGEN]) == tg, bar);
            __builtin_amdgcn_fence(__ATOMIC_ACQUIRE, "agent");
            xb_add(&bar[XB_XGEN(b.x)], 1u);
            asm volatile("s_waitcnt vmcnt(0)" ::: "memory");
        } else {
            XB_SPIN(xb_ld(&bar[XB_XGEN(b.x)]) == gen, bar);
            __builtin_amdgcn_fence(__ATOMIC_ACQUIRE, "agent");
            asm volatile("s_waitcnt vmcnt(0)" ::: "memory");
        }
    }
    __syncthreads();
}


struct KArgs { const float* x; const float* c; const float* w_ada; const float* b_ada; const float* w_in; const float* b_f; const float* w_out; const float* ln_g; const float* ln_b; float* out; unsigned char* ws; int ph_lo; int ph_hi; };

__device__ __forceinline__ void transpose_item(const float* __restrict__ W, int ldw, int srccol0, int k0, bf16* __restrict__ WT, int K, int dstrow0, float scale, LAS float* scr, int lane) {
#pragma unroll 8
    for (int i = 0; i < 32; ++i) { const int kk = 2 * i + (lane >> 5); scr[kk * 33 + (lane & 31)] = W[(size_t)(k0 + kk) * ldw + srccol0 + (lane & 31)]; }
    asm volatile("s_waitcnt lgkmcnt(0)" ::: "memory");
    const int c = lane & 7;
#pragma unroll
    for (int j = 0; j < 4; ++j) { const int n = (lane >> 3) + 8 * j; const LAS float* s = scr + (8 * c) * 33 + n;
        u32x4 o; o.x = pk2(s[0] * scale, s[33] * scale); o.y = pk2(s[66] * scale, s[99] * scale); o.z = pk2(s[132] * scale, s[165] * scale); o.w = pk2(s[198] * scale, s[231] * scale);
        *(u32x4*)(WT + (size_t)(dstrow0 + n) * K + k0 + 8 * c) = o; }
    asm volatile("s_waitcnt lgkmcnt(0)" ::: "memory");
}

__global__ void __launch_bounds__(512) fwd_kernel(KArgs a) {
    extern __shared__ __attribute__((aligned(16))) unsigned char lds_raw[];
    LAS unsigned char* lds = (LAS unsigned char*)lds_raw;
    cg::grid_group grid = cg::this_grid();
    const int tid = threadIdx.x, lane = tid & 63, wid = __builtin_amdgcn_readfirstlane(tid >> 6);
    const int blk = blockIdx.x, G = gridDim.x;
    unsigned char* ws = a.ws;
    unsigned* ctl = (unsigned*)(ws + WS_CTL);
    bf16* WTin = (bf16*)(ws + WS_WTIN); bf16* WTout = (bf16*)(ws + WS_WTOUT);
    float* modv = (float*)(ws + WS_MOD); float* LF = (float*)(ws + WS_LF); float* Fc = (float*)(ws + WS_F);
    bf16* U = (bf16*)(ws + WS_U); bf16* Hb = (bf16*)(ws + WS_H); bf16* Yb = (bf16*)(ws + WS_Y);
    volatile LAS unsigned* xbst = (volatile LAS unsigned*)(lds + 131072);
    if (tid < 2) xbst[tid] = 0u;
    __syncthreads();
    XcdBarrier xbar = xcd_barrier_post(ctl + CW_BAR, xbst);
    if (a.ph_lo > 1000) grid.sync();
    const int lo = a.ph_lo, hi_ = a.ph_hi;
#define IN(k) (lo <= (k) && (k) < hi_)
#define BOTH(k) (IN(k) && IN((k) + 1))

    PHASE_REP(0) { if (rep) grid.sync();
    if (IN(0)) {
        if (blk < 96) {
            LAS float* sc = (LAS float*)lds; LAS float* red = (LAS float*)(lds + 8192);
            for (int i = tid; i < 2048; i += 512) sc[i] = silu_f(a.c[i]);
            __syncthreads();
            const int n = tid & 31, kg = tid >> 5, col = 32 * blk + n;
            float a0 = 0.f, a1 = 0.f;
#pragma unroll 8
            for (int k = 64 * kg; k < 64 * kg + 64; ++k) { const float w = a.w_ada[(size_t)k * 3072 + col]; a0 += sc[k] * w; a1 += sc[1024 + k] * w; }
            red[(kg * 32 + n) * 2] = a0; red[(kg * 32 + n) * 2 + 1] = a1;
            __syncthreads();
            if (tid < 64) { const int nn = tid & 31, bb = tid >> 5; float s = a.b_ada[32 * blk + nn];
                for (int g = 0; g < 16; ++g) s += red[(g * 32 + nn) * 2 + bb];
                modv[bb * 3072 + 32 * blk + nn] = s; }
            __syncthreads();
        }
        LAS float* scr = (LAS float*)(lds + wid * 16384);
        const int gw = blk * 8 + wid, NGW = G * 8;
        for (int it = gw; it < 2048 + 512; it += NGW) {
            if (it < 2048) { const int nb = it & 127, kb = it >> 7, n0 = 32 * nb;
                const float scl = (n0 < 512 || (n0 >= 2048 && n0 < 2560)) ? C2 : 1.f;
                transpose_item(a.w_in, INW, n0 + (n0 >= 2048 ? 8 : 0), 64 * kb, WTin, 1024, n0, scl, scr, lane);
            } else { const int r = it - 2048, nb = r & 31, kb = r >> 5;
                transpose_item(a.w_out, 1024, 32 * nb, 64 * kb, WTout, 1024, 32 * nb, 1.f, scr, lane); }
        }
        __syncthreads();
    }
    }
    if (BOTH(0)) xcd_barrier(xbar);

    PHASE_REP(1) { if (rep) grid.sync();
    if (IN(1)) {
        LAS float* wff = (LAS float*)lds;
        for (int i = tid; i < 2048; i += 512) { const int col = i >> 1, half = i & 1; const f32x4 v = *(const f32x4*)(a.w_in + (size_t)col * INW + 2048 + 4 * half);
            wff[(4 * half + 0) * 1024 + col] = v[0]; wff[(4 * half + 1) * 1024 + col] = v[1]; wff[(4 * half + 2) * 1024 + col] = v[2]; wff[(4 * half + 3) * 1024 + col] = v[3]; }
        __syncthreads();
        for (int rb = blk; rb < MROWS / 64; rb += G) {
            const int b = rb >> 7;
            f32x4 sc1[4], sh[4];
#pragma unroll
            for (int j = 0; j < 4; ++j) { sh[j] = *(const f32x4*)(modv + b * 3072 + 4 * (lane + 64 * j)); sc1[j] = *(const f32x4*)(modv + b * 3072 + 1024 + 4 * (lane + 64 * j)) + 1.f; }
            const float bfl = a.b_f[lane & 7];
            for (int i = 0; i < 8; ++i) {
                const int row = rb * 64 + wid * 8 + i;
                const f32x4* xr = (const f32x4*)(a.x + (size_t)row * DMODEL) + lane;
                f32x4 v[4]; float s = 0.f;
#pragma unroll
                for (int j = 0; j < 4; ++j) { v[j] = xr[64 * j]; s += (v[j][0] + v[j][1]) + (v[j][2] + v[j][3]); }
                const float mean = wave_sum(s) * (1.f / DMODEL); float s2 = 0.f;
#pragma unroll
                for (int j = 0; j < 4; ++j) { v[j] = v[j] - mean; s2 += (v[j][0] * v[j][0] + v[j][1] * v[j][1]) + (v[j][2] * v[j][2] + v[j][3] * v[j][3]); }
                const float rstd = 1.f / sqrtf(wave_sum(s2) * (1.f / DMODEL) + LN_EPS);
                u32x2* o8 = (u32x2*)(U + (size_t)row * DMODEL) + lane;
#pragma unroll
                for (int j = 0; j < 4; ++j) { v[j] = v[j] * rstd * sc1[j] + sh[j]; u32x2 w; w.x = pk2(v[j][0], v[j][1]); w.y = pk2(v[j][2], v[j][3]); o8[64 * j] = w; }
                float ffv = 0.f;
#pragma unroll
                for (int q = 0; q < 8; ++q) { float d = 0.f;
#pragma unroll
                    for (int j = 0; j < 4; ++j) { const f32x4 w = *(const LAS f32x4*)(wff + q * 1024 + 4 * (lane + 64 * j)); d += (v[j][0] * w[0] + v[j][1] * w[1]) + (v[j][2] * w[2] + v[j][3] * w[3]); }
                    d = wave_sum(d); if (lane == q) ffv = d; }
                if (lane < 8) { const float t = ffv + bfl; const float ls = fminf(t, 0.f) - log1pf(__expf(-fabsf(t))); LF[(size_t)(b * 8 + lane) * SEQ + (row & (SEQ - 1))] = ls * LOG2E; }
            }
        }
        __syncthreads();
    }
    }
    if (BOTH(1)) xcd_barrier(xbar);

    {
    if (IN(2)) {
        for (int sq = blk; sq < 16; sq += G) {
            const float* src = LF + (size_t)sq * SEQ + tid * 16; f32x4 v[4]; float run = 0.f;
#pragma unroll
            for (int j = 0; j < 4; ++j) { v[j] = *(const f32x4*)(src + 4 * j);
#pragma unroll
                for (int e = 0; e < 4; ++e) { run += v[j][e]; v[j][e] = run; } }
            float xs = run;
#pragma unroll
            for (int o = 1; o < 64; o <<= 1) { const float y = __shfl_up(xs, o); if (lane >= o) xs += y; }
            LAS float* wt = (LAS float*)lds;
            if (lane == 63) wt[wid] = xs;
            __syncthreads();
            float off = xs - run;
            for (int w = 0; w < wid; ++w) off += wt[w];
            float* dst = Fc + (size_t)sq * SEQ + tid * 16;
#pragma unroll
            for (int j = 0; j < 4; ++j) *(f32x4*)(dst + 4 * j) = v[j] + off;
            __syncthreads();
        }
        pg8::Gemm g{U, WTin, MROWS, HP, 1024}; StaticOrderRep S; S.init(MROWS, HP, G, blk, REPK == 2 ? 2 : 1);
        EpiH E{Hb, ctl + CW_KMAX};
        pg8::gemm_phase<EpiH, StaticOrderRep, true, true>(lds, g, S, E);
    }
    }
    if (BOTH(2)) xcd_barrier(xbar);

    PHASE_REP(3) { if (rep) grid.sync();
    if (IN(3)) {
        for (;;) {
            if (tid == 0) *(LAS unsigned*)(lds + att::L_UNIT) = atomicAdd(ctl + CW_CTR + rep, 1u);
            __syncthreads();
            const unsigned u = (unsigned)__builtin_amdgcn_readfirstlane(*(const LAS unsigned*)(lds + att::L_UNIT));
            if (u >= 1024u) break;
            const int v = (int)(u & 511u), qb = 31 - (v >> 4), bh = v & 15;
            if (u < 512u) att::unit<true>(Hb, Fc, ctl + CW_KMAX, Yb, bh >> 3, bh & 7, qb, lds);
            else att::unit<false>(Hb, Fc, ctl + CW_KMAX, Yb, bh >> 3, bh & 7, qb, lds);
            __syncthreads();
        }
    }
    }
    if (BOTH(3)) xcd_barrier(xbar);

    {
    if (IN(4)) {
        pg8::Gemm g{Yb, WTout, MROWS, DMODEL, 1024}; StaticOrderRep S; S.init(MROWS, DMODEL, G, blk, REPK == 4 ? 2 : 1);
        EpiResid E{a.x, modv, a.out};
        pg8::gemm_phase<EpiResid, StaticOrderRep, true, true>(lds, g, S, E);
    }
    }
    if (BOTH(4)) xcd_barrier(xbar);

    if (IN(5)) {
        f32x4 gv[4], bv[4];
#pragma unroll
        for (int j = 0; j < 4; ++j) { gv[j] = *(const f32x4*)(a.ln_g + 4 * (lane + 64 * j)); bv[j] = *(const f32x4*)(a.ln_b + 4 * (lane + 64 * j)); }
        for (int row = blk * 8 + wid; row < MROWS; row += G * 8) {
            f32x4* xr = (f32x4*)(a.out + (size_t)row * DMODEL) + lane;
            f32x4 v[4]; float s = 0.f;
#pragma unroll
            for (int j = 0; j < 4; ++j) { v[j] = xr[64 * j]; s += (v[j][0] + v[j][1]) + (v[j][2] + v[j][3]); }
            const float mean = wave_sum(s) * (1.f / DMODEL); float s2 = 0.f;
#pragma unroll
            for (int j = 0; j < 4; ++j) { v[j] = v[j] - mean; s2 += (v[j][0] * v[j][0] + v[j][1] * v[j][1]) + (v[j][2] * v[j][2] + v[j][3] * v[j][3]); }
            const float rstd = 1.f / sqrtf(wave_sum(s2) * (1.f / DMODEL) + LN_EPS);
#pragma unroll
            for (int j = 0; j < 4; ++j) xr[64 * j] = v[j] * rstd * gv[j] + bv[j];
        }
    }
#undef IN
#undef BOTH
}

extern "C" void kernel_launch(void* const* d_in, const int* in_sizes, int n_in, void* d_out, int out_size, void* d_ws, size_t ws_size, hipStream_t stream) {
    static int grid = 0;
    if (grid == 0) {
        if (n_in != 9 || out_size != MROWS * DMODEL || ws_size < WS_END) { fprintf(stderr, "kernel_launch: unexpected shapes (n_in %d, out %d, ws %zu)\n", n_in, out_size, ws_size); grid = -1; return; }
        if (hipFuncSetAttribute((const void*)fwd_kernel, hipFuncAttributeMaxDynamicSharedMemorySize, LDS_BYTES) != hipSuccess) { fprintf(stderr, "kernel_launch: hipFuncSetAttribute failed\n"); grid = -1; return; }
        int dev = 0, cus = 0, per_cu = 0;
        (void)hipGetDevice(&dev); (void)hipDeviceGetAttribute(&cus, hipDeviceAttributeMultiprocessorCount, dev);
        if (hipOccupancyMaxActiveBlocksPerMultiprocessor(&per_cu, (const void*)fwd_kernel, 512, LDS_BYTES) != hipSuccess || per_cu < 1) { fprintf(stderr, "kernel_launch: occupancy query says %d blocks per CU\n", per_cu); per_cu = 1; }
        (void)hipGetLastError();
        grid = cus > 0 ? cus : 256;
    }
    if (grid < 0) return;
    if (hipMemsetAsync((char*)d_ws + WS_CTL, 0, CW_WORDS * 4, stream) != hipSuccess) { fprintf(stderr, "kernel_launch: memset failed\n"); return; }
    KArgs a{};
    a.x = (const float*)d_in[0]; a.c = (const float*)d_in[1]; a.w_ada = (const float*)d_in[2]; a.b_ada = (const float*)d_in[3]; a.w_in = (const float*)d_in[4];
    a.b_f = (const float*)d_in[5]; a.w_out = (const float*)d_in[6]; a.ln_g = (const float*)d_in[7]; a.ln_b = (const float*)d_in[8];
    a.out = (float*)d_out; a.ws = (unsigned char*)d_ws;
#if N_LAUNCHES == 1
    a.ph_lo = 0; a.ph_hi = 6;
    void* args[] = {&a};
    const hipError_t e = hipLaunchCooperativeKernel((const void*)fwd_kernel, dim3(grid), dim3(512), args, LDS_BYTES, stream);
    if (e != hipSuccess) fprintf(stderr, "kernel_launch: cooperative launch failed: %s (grid %d)\n", hipGetErrorString(e), grid);
#else
    for (int p = 0; p < 6; ++p) { a.ph_lo = p; a.ph_hi = p + 1; hipLaunchKernelGGL(fwd_kernel, dim3(grid), dim3(512), LDS_BYTES, stream, a); }
#endif
}
```

```cpp
#include <hip/hip_runtime.h>
#include <hip/hip_cooperative_groups.h>
#include <cstdio>
#include <cstdint>
namespace cg = cooperative_groups;
namespace pg8 {
#define PG8_LAS __attribute__((address_space(3)))
typedef unsigned short bf16_t;
typedef short bf16x8 __attribute__((ext_vector_type(8)));
typedef float f32x4 __attribute__((ext_vector_type(4)));
typedef unsigned u32x4 __attribute__((ext_vector_type(4)));
constexpr int BM = 256, BK = 64, HALF = 128, HTB = HALF * BK * 2  , STAGE_BYTES = 8 * HTB, NXCD = 8, WGM = 8;

__host__ __device__ __forceinline__ int lds_byte(int r, int c) { const int st = (r >> 4) * 2 + (c >> 5), rr = r & 15, cc = c & 31, ob = rr * 64 + cc * 2; return st * 1024 + (ob ^ (((ob >> 9) & 1) << 5)); }
__host__ __device__ __forceinline__ void stage_rc(int b, int& R, int& C) { const int st = b / 1024, sb = b % 1024, swz = sb ^ (((sb >> 9) & 1) << 5); R = (st >> 1) * 16 + swz / 64; C = (st & 1) * 32 + (swz % 64) / 2; }
__host__ __device__ __forceinline__ int perm32(int rho) { const int n = rho >> 4, i = rho & 15; return 8 * (i >> 2) + 4 * n + (i & 3); }

struct Unit { int pm, pn; };
struct Gemm { const bf16_t* A; const bf16_t* Bt; int M, N, K; };

struct StaticOrder {
    int nM, nN, nwg, G, c;
    __host__ __device__ void init(int M, int N, int G_, int c_) { nM = M / BM; nN = N / BM; nwg = nM * nN; G = G_; c = c_; }
    __host__ __device__ bool next(int i, Unit& u) const {
        const long L = (long)i * G + c; if (L >= nwg) return false;
        int wgid = (int)L; { const int q = nwg / NXCD, r = nwg % NXCD, xcd = wgid % NXCD, off = wgid / NXCD; wgid = (xcd < r ? xcd * (q + 1) : r * (q + 1) + (xcd - r) * q) + off; }
        const int nig = WGM * nN, gid = wgid / nig, fm = gid * WGM, gsz = (nM - fm) < WGM ? (nM - fm) : WGM;
        u.pm = fm + ((wgid % nig) % gsz); u.pn = (wgid % nig) / gsz; return true;
    }
    __device__ __forceinline__ void a_ready(const Unit&) const {}
    __device__ __forceinline__ void done(const Unit&) const {}
};

__device__ __forceinline__ unsigned cvt_pk_bf16(float lo, float hi) { unsigned r; asm volatile("v_cvt_pk_bf16_f32 %0, %1, %2" : "=v"(r) : "v"(lo), "v"(hi)); return r; }
typedef float f32x2 __attribute__((ext_vector_type(2)));
__device__ __forceinline__ f32x2 gelu_pk(f32x2 v) {
    const f32x2 av = __builtin_elementwise_abs(v), d = av * 0.2316418882f + 1.0f;
    f32x2 t; t.x = __builtin_amdgcn_rcpf(d.x); t.y = __builtin_amdgcn_rcpf(d.y);
    f32x2 q = t * 0.5307027145f + (-0.7265760135f); q = q * t + 0.7107068705f; q = q * t + (-0.142248368f); q = q * t + 0.127414796f; q = q * t;
    const f32x2 s = (v * v) * (-0.72134752044f);
    f32x2 e; e.x = __builtin_amdgcn_exp2f(s.x); e.y = __builtin_amdgcn_exp2f(s.y);
    const f32x2 m = v * (q * e), r = v - m;
    f32x2 o; o.x = v.x < 0.f ? m.x : r.x; o.y = v.y < 0.f ? m.y : r.y; return o;
}

template <int ACT  > struct EpiBf16 {
    static constexpr bool PERM = true, AFTER_DRAIN = false; static_assert(ACT == 0 || ACT == 1, "EpiBf16: ACT is 0 (none) or 1 (gelu_pk)");
    bf16_t* O; int ldc; const float* bias; int split_cols; size_t split_stride; float scale0;
    __device__ __forceinline__ void operator()(const f32x4 (&acc)[2][2][4][2], const Unit& u, int wr, int wc, int fr, int fq) const {
        const int row0 = u.pm * BM + wr * 64 + fr; int colt = u.pn * BM; bf16_t* base = O;
        float sc = 1.f; if (split_cols) { const int t = colt / split_cols; base += (size_t)t * split_stride; colt -= t * split_cols; if (t == 0) sc = scale0; }
        const int col0 = colt + wc * 32 + 8 * fq, bcol0 = u.pn * BM + wc * 32 + 8 * fq;
        f32x4 bv[2][2];
#pragma unroll
        for (int bj = 0; bj < 2; ++bj)
#pragma unroll
            for (int n = 0; n < 2; ++n) bv[bj][n] = bias ? *(const f32x4*)(bias + bcol0 + bj * HALF + 4 * n) : (f32x4){0.f, 0.f, 0.f, 0.f};
#pragma unroll
        for (int ai = 0; ai < 2; ++ai)
#pragma unroll
            for (int m = 0; m < 4; ++m) { bf16_t* rowp = base + (size_t)(row0 + ai * HALF + m * 16) * ldc + col0;
#pragma unroll
                for (int bj = 0; bj < 2; ++bj) { f32x4 v0 = acc[ai][bj][m][0] + bv[bj][0], v1 = acc[ai][bj][m][1] + bv[bj][1];
                    if (ACT == 1) { f32x2 a = gelu_pk((f32x2){v0[0], v0[1]}), b = gelu_pk((f32x2){v0[2], v0[3]}), c = gelu_pk((f32x2){v1[0], v1[1]}), d = gelu_pk((f32x2){v1[2], v1[3]});
                        v0 = (f32x4){a.x, a.y, b.x, b.y}; v1 = (f32x4){c.x, c.y, d.x, d.y}; }
                    v0 = v0 * sc; v1 = v1 * sc; u32x4 w; w.x = cvt_pk_bf16(v0[0], v0[1]); w.y = cvt_pk_bf16(v0[2], v0[3]); w.z = cvt_pk_bf16(v1[0], v1[1]); w.w = cvt_pk_bf16(v1[2], v1[3]);
                    *(u32x4*)(rowp + bj * HALF) = w; } }
    }
};

template <class Epi, class Sched, bool ALIGN_EPI = false, bool SP2 = false>
__device__ __forceinline__ void gemm_phase(PG8_LAS unsigned char* lds, const Gemm g, const Sched& S, const Epi& E) {
    const int tid = threadIdx.x, wid = __builtin_amdgcn_readfirstlane(tid >> 6), lane = tid & 63, wr = wid >> 2, wc = wid & 3, fr = lane & 15, fq = lane >> 4;
    const int K = g.K, nt = K / BK;
    unsigned voffA[2], voffB[2];
#pragma unroll
    for (int i = 0; i < 2; ++i) { int R, C; stage_rc(tid * 16 + i * 8192, R, C); const int Rb = Epi::PERM ? ((R & ~31) + perm32(R & 31)) : R;
        voffA[i] = (unsigned)(R * K + C) * 2u; voffB[i] = (unsigned)(Rb * K + C) * 2u; }
    const size_t kstep = (size_t)(BK * 2);
    const size_t hstep = (size_t)HALF * K * 2;
    const size_t tstep = 2 * hstep;
    const unsigned ldsw = (unsigned)wid * 1024u;
    const int aoff = lds_byte(wr * 64 + fr, fq * 8), boff = lds_byte(wc * 32 + fr, fq * 8);
#define PG8_SA(b, h) (((b) * 2 + (h)) * HTB)
#define PG8_SB(b, h) ((4 + (b) * 2 + (h)) * HTB)
#define PG8_STAGE(bufoff, gbase, voff) do { _Pragma("unroll") for (int _i = 0; _i < 2; ++_i) \
        __builtin_amdgcn_global_load_lds((const unsigned*)((const char*)(gbase) + (voff)[_i]), (PG8_LAS unsigned*)(lds + (bufoff) + ldsw + _i * 8192), 16, 0, 0); } while (0)
#define PG8_LDA(dst, b, h) do { _Pragma("unroll") for (int m = 0; m < 4; ++m) _Pragma("unroll") for (int k = 0; k < 2; ++k) dst[m][k] = *(const PG8_LAS bf16x8*)(lds + PG8_SA(b, h) + aoff + m * 2048 + k * 1024); } while (0)
#define PG8_LDB(dst, b, h) do { _Pragma("unroll") for (int n = 0; n < 2; ++n) _Pragma("unroll") for (int k = 0; k < 2; ++k) dst[n][k] = *(const PG8_LAS bf16x8*)(lds + PG8_SB(b, h) + boff + n * 2048 + k * 1024); } while (0)
#define PG8_MMA(ai, bj, At, Bt) do { __builtin_amdgcn_s_setprio(1); _Pragma("unroll") for (int m = 0; m < 4; ++m) _Pragma("unroll") for (int n = 0; n < 2; ++n) _Pragma("unroll") for (int k = 0; k < 2; ++k) \
        acc[ai][bj][m][n] = __builtin_amdgcn_mfma_f32_16x16x32_bf16(Bt[n][k], At[m][k], acc[ai][bj][m][n], 0, 0, 0); __builtin_amdgcn_s_setprio(0); } while (0)
#define PG8_WAIT_V(n) asm volatile("s_waitcnt vmcnt(" #n ")" ::: "memory")
#define PG8_WAIT_L(n) asm volatile("s_waitcnt lgkmcnt(" #n ")" ::: "memory")
#define PG8_BAR __builtin_amdgcn_s_barrier()
#define PG8_SCHED __builtin_amdgcn_sched_barrier(0)
    Unit cur, nxt; int ui = 0;
    if (!S.next(0, cur)) return;
    f32x4 acc[2][2][4][2];
#pragma unroll
    for (int a = 0; a < 2; ++a)
#pragma unroll
        for (int b = 0; b < 2; ++b)
#pragma unroll
            for (int m = 0; m < 4; ++m)
#pragma unroll
                for (int n = 0; n < 2; ++n) acc[a][b][m][n] = (f32x4){0.f, 0.f, 0.f, 0.f};
    bf16x8 At[4][2], B0[2][2], B1[2][2];
    const char* cA = (const char*)g.A + (size_t)cur.pm * tstep; const char* cB = (const char*)g.Bt + (size_t)cur.pn * tstep;
    S.a_ready(cur);
    if constexpr (SP2) {
        PG8_STAGE(PG8_SB(0, 0), cB, voffB); PG8_STAGE(PG8_SB(0, 1), cB + hstep, voffB); PG8_STAGE(PG8_SA(0, 0), cA, voffA); PG8_STAGE(PG8_SA(0, 1), cA + hstep, voffA);
        if (wr == 1) PG8_BAR;
        PG8_WAIT_V(2); PG8_BAR;
        PG8_STAGE(PG8_SB(1, 0), cB + kstep, voffB); PG8_STAGE(PG8_SA(1, 0), cA + kstep, voffA); PG8_STAGE(PG8_SB(1, 1), cB + hstep + kstep, voffB);
        PG8_WAIT_V(6); PG8_BAR;
    } else {
        PG8_STAGE(PG8_SB(0, 0), cB, voffB); PG8_STAGE(PG8_SA(0, 0), cA, voffA); PG8_STAGE(PG8_SB(0, 1), cB + hstep, voffB); PG8_STAGE(PG8_SA(0, 1), cA + hstep, voffA);
        if (wr == 1) PG8_BAR;
        PG8_WAIT_V(4); PG8_BAR;
        PG8_STAGE(PG8_SB(1, 0), cB + kstep, voffB); PG8_STAGE(PG8_SA(1, 0), cA + kstep, voffA); PG8_STAGE(PG8_SB(1, 1), cB + hstep + kstep, voffB);
        PG8_WAIT_V(6); PG8_BAR;
    }
    for (;;) {
        const bool has_next = S.next(ui + 1, nxt);
        const char* nA = has_next ? (const char*)g.A + (size_t)nxt.pm * tstep : cA; const char* nB = has_next ? (const char*)g.Bt + (size_t)nxt.pn * tstep : cB;
        for (int t = 0; t < nt; t += 2) {
            const bool last = (t == nt - 2);
            const char* a1 = cA + (size_t)(t + 1) * kstep;
            const char* a2 = last ? nA : cA + (size_t)(t + 2) * kstep; const char* b2 = last ? nB : cB + (size_t)(t + 2) * kstep;
            const char* a3 = a2 + kstep; const char* b3 = b2 + kstep;
            if (last && has_next) S.a_ready(nxt);
            if constexpr (SP2) {
            PG8_LDB(B0, 0, 0); PG8_LDB(B1, 0, 1); PG8_SCHED; PG8_LDA(At, 0, 0); PG8_STAGE(PG8_SA(1, 1), a1 + hstep, voffA);
            PG8_WAIT_V(8); PG8_WAIT_L(0); PG8_BAR; PG8_MMA(0, 0, At, B0); PG8_MMA(0, 1, At, B1); PG8_BAR; PG8_SCHED;
            PG8_LDA(At, 0, 1); PG8_STAGE(PG8_SB(0, 0), b2, voffB); PG8_STAGE(PG8_SB(0, 1), b2 + hstep, voffB); PG8_STAGE(PG8_SA(0, 0), a2, voffA);
            PG8_WAIT_V(8); PG8_WAIT_L(0); PG8_BAR; PG8_MMA(1, 0, At, B0); PG8_MMA(1, 1, At, B1); PG8_BAR; PG8_SCHED;
            PG8_LDB(B0, 1, 0); PG8_LDB(B1, 1, 1); PG8_SCHED; PG8_LDA(At, 1, 0); PG8_STAGE(PG8_SA(0, 1), a2 + hstep, voffA);
            PG8_WAIT_V(8); PG8_WAIT_L(0); PG8_BAR; PG8_MMA(0, 0, At, B0); PG8_MMA(0, 1, At, B1); PG8_BAR; PG8_SCHED;
            PG8_LDA(At, 1, 1); PG8_STAGE(PG8_SB(1, 0), b3, voffB); PG8_STAGE(PG8_SB(1, 1), b3 + hstep, voffB); PG8_STAGE(PG8_SA(1, 0), a3, voffA);
            PG8_WAIT_V(8); PG8_WAIT_L(0); PG8_BAR; PG8_MMA(1, 0, At, B0); PG8_MMA(1, 1, At, B1); PG8_BAR; PG8_SCHED;
            } else {
            PG8_LDB(B0, 0, 0); PG8_SCHED; PG8_LDA(At, 0, 0); PG8_STAGE(PG8_SA(1, 1), a1 + hstep, voffA);
            PG8_WAIT_L(8); PG8_BAR; PG8_WAIT_L(0); PG8_MMA(0, 0, At, B0); PG8_BAR; PG8_SCHED;
            PG8_LDB(B1, 0, 1); PG8_STAGE(PG8_SB(0, 0), b2, voffB);
            PG8_BAR; PG8_WAIT_L(0); PG8_MMA(0, 1, At, B1); PG8_BAR;
            PG8_LDA(At, 0, 1); PG8_STAGE(PG8_SA(0, 0), a2, voffA);
            PG8_BAR; PG8_WAIT_L(0); PG8_MMA(1, 0, At, B0); PG8_BAR; PG8_SCHED;
            PG8_STAGE(PG8_SB(0, 1), b2 + hstep, voffB);
            PG8_WAIT_V(6); PG8_BAR; PG8_MMA(1, 1, At, B1); PG8_BAR;
            PG8_LDB(B0, 1, 0); PG8_SCHED; PG8_LDA(At, 1, 0); PG8_STAGE(PG8_SA(0, 1), a2 + hstep, voffA);
            PG8_WAIT_L(8); PG8_BAR; PG8_WAIT_L(0); PG8_MMA(0, 0, At, B0); PG8_BAR; PG8_SCHED;
            PG8_LDB(B1, 1, 1); PG8_STAGE(PG8_SB(1, 0), b3, voffB);
            PG8_BAR; PG8_WAIT_L(0); PG8_MMA(0, 1, At, B1); PG8_BAR;
            PG8_LDA(At, 1, 1); PG8_STAGE(PG8_SA(1, 0), a3, voffA);
            PG8_BAR; PG8_WAIT_L(0); PG8_MMA(1, 0, At, B0); PG8_BAR; PG8_SCHED;
            PG8_STAGE(PG8_SB(1, 1), b3 + hstep, voffB);
            PG8_WAIT_V(6); PG8_BAR; PG8_MMA(1, 1, At, B1); PG8_BAR;
            }
        }
        if constexpr (ALIGN_EPI) { if (wr == 0) PG8_BAR; }
        if constexpr (!Epi::AFTER_DRAIN) { E(acc, cur, wr, wc, fr, fq); S.done(cur); }
        if (!has_next) break;
#pragma unroll
        for (int a = 0; a < 2; ++a)
#pragma unroll
            for (int b = 0; b < 2; ++b)
#pragma unroll
                for (int m = 0; m < 4; ++m)
#pragma unroll
                    for (int n = 0; n < 2; ++n) acc[a][b][m][n] = (f32x4){0.f, 0.f, 0.f, 0.f};
        cur = nxt; cA = nA; cB = nB; ++ui;
        if constexpr (ALIGN_EPI) { if (wr == 1) PG8_BAR; }
    }
    PG8_WAIT_V(0);
    if constexpr (!ALIGN_EPI) { if (wr == 0) PG8_BAR; }
    PG8_BAR;
    if constexpr (Epi::AFTER_DRAIN) { E.fused(acc, cur, wr, wc, fr, fq, lds, wid, lane); S.done(cur); }
#undef PG8_SA
#undef PG8_SB
#undef PG8_STAGE
#undef PG8_LDA
#undef PG8_LDB
#undef PG8_MMA
#undef PG8_WAIT_V
#undef PG8_WAIT_L
#undef PG8_BAR
#undef PG8_SCHED
}
}

constexpr int SEQ = 8192, DMODEL = 1024, MROWS = 16384, HP = 4096, INW = 4104;
constexpr float LOG2E = 1.4426950408889634f;
constexpr float C2 = 0.125f * LOG2E;
constexpr float DN_ALPHA = 1.189207115002721f;
constexpr float LN_EPS = 1e-5f;
constexpr size_t MiB = 1u << 20;
constexpr size_t WS_CTL = 0, WS_WTIN = 1 * MiB, WS_WTOUT = 9 * MiB, WS_MOD = 11 * MiB, WS_LF = 12 * MiB, WS_F = 13 * MiB, WS_U = 16 * MiB, WS_H = 48 * MiB, WS_Y = 176 * MiB, WS_END = 208 * MiB;
constexpr int CW_CTR = 0, CW_KMAX = 64, CW_BAR = 4096, CW_WORDS = 8192;
constexpr int LDS_BYTES = 147456;
#ifndef N_LAUNCHES
#define N_LAUNCHES 1
#endif
#ifndef REPK
#define REPK -1
#endif
#define PHASE_REP(k) for (int rep = 0; rep < ((REPK == (k)) ? 2 : 1); ++rep)

#define LAS __attribute__((address_space(3)))
typedef unsigned short bf16;
typedef short bf16x8 __attribute__((ext_vector_type(8)));
typedef short s16x4 __attribute__((ext_vector_type(4)));
typedef float f32x4 __attribute__((ext_vector_type(4)));
typedef float f32x16 __attribute__((ext_vector_type(16)));
typedef unsigned u32x4 __attribute__((ext_vector_type(4)));
typedef unsigned u32x2 __attribute__((ext_vector_type(2)));

__device__ __forceinline__ unsigned pk2(float lo, float hi) {
    typedef float f2_t __attribute__((ext_vector_type(2))); typedef __bf16 b2_t __attribute__((ext_vector_type(2)));
    f2_t v = {lo, hi}; b2_t b = __builtin_convertvector(v, b2_t); return __builtin_bit_cast(unsigned, b);
}
__device__ __forceinline__ float bf2f(unsigned short u) { return __uint_as_float(((unsigned)u) << 16); }
__device__ __forceinline__ float wave_sum(float v) {
#pragma unroll
    for (int o = 1; o < 64; o <<= 1) v += __shfl_xor(v, o);
    return v;
}
__device__ __forceinline__ float silu_f(float v) { return v / (1.f + __expf(-v)); }

struct EpiH {
    static constexpr bool PERM = true, AFTER_DRAIN = false;
    bf16* O; unsigned* kmax;
    __device__ __forceinline__ void operator()(const pg8::f32x4 (&acc)[2][2][4][2], const pg8::Unit& u, int wr, int wc, int fr, int fq) const {
        const int row0 = u.pm * 256 + wr * 64 + fr, col0 = u.pn * 256 + wc * 32 + 8 * fq;
        const bool isK = (u.pn == 2 || u.pn == 3);
        float mx[2] = {0.f, 0.f};
#pragma unroll
        for (int ai = 0; ai < 2; ++ai)
#pragma unroll
            for (int m = 0; m < 4; ++m) { bf16* rowp = O + (size_t)(row0 + ai * 128 + m * 16) * HP + col0;
#pragma unroll
                for (int bj = 0; bj < 2; ++bj) { const pg8::f32x4 v0 = acc[ai][bj][m][0], v1 = acc[ai][bj][m][1];
                    u32x4 w; w.x = pk2(v0[0], v0[1]); w.y = pk2(v0[2], v0[3]); w.z = pk2(v1[0], v1[1]); w.w = pk2(v1[2], v1[3]);
                    *(u32x4*)(rowp + bj * 128) = w;
                    if (isK) { float ss = (v0[0] * v0[0] + v0[1] * v0[1]) + (v0[2] * v0[2] + v0[3] * v0[3]) + (v1[0] * v1[0] + v1[1] * v1[1]) + (v1[2] * v1[2] + v1[3] * v1[3]);
                        ss += __shfl_xor(ss, 16); ss += __shfl_xor(ss, 32); mx[bj] = fmaxf(mx[bj], ss); } } }
        if (isK) {
#pragma unroll
            for (int bj = 0; bj < 2; ++bj) { float v = mx[bj];
#pragma unroll
                for (int o = 1; o < 16; o <<= 1) v = fmaxf(v, __shfl_xor(v, o));
                const int head = (u.pn * 256 + bj * 128 + wc * 32 - 512) >> 6, b = (u.pm >= 32) ? 1 : 0;
                if ((threadIdx.x & 63) == 0) atomicMax(kmax + ((b * 8 + head) * 2 + (wc & 1)), __float_as_uint(v)); }
        }
    }
};
struct EpiResid {
    static constexpr bool PERM = false, AFTER_DRAIN = false;
    const float* x; const float* mod; float* out;
    __device__ __forceinline__ void operator()(const pg8::f32x4 (&acc)[2][2][4][2], const pg8::Unit& u, int wr, int wc, int fr, int fq) const {
        const int b = (u.pm >= 32) ? 1 : 0; const int col0 = u.pn * 256 + wc * 32 + 4 * fq;
#pragma unroll
        for (int bj = 0; bj < 2; ++bj)
#pragma unroll
            for (int n = 0; n < 2; ++n) { const int col = col0 + bj * 128 + n * 16; const pg8::f32x4 g = *(const pg8::f32x4*)(mod + b * 3072 + 2048 + col);
#pragma unroll
                for (int ai = 0; ai < 2; ++ai)
#pragma unroll
                    for (int m = 0; m < 4; ++m) { const size_t off = (size_t)(u.pm * 256 + ai * 128 + wr * 64 + m * 16 + fr) * DMODEL + col;
                        const pg8::f32x4 xv = *(const pg8::f32x4*)(x + off); *(pg8::f32x4*)(out + off) = xv * DN_ALPHA + g * acc[ai][bj][m][n]; } }
    }
};

struct StaticOrderRep {
    pg8::StaticOrder S; int rounds, reps;
    __device__ void init(int M, int N, int G, int c, int reps_) { S.init(M, N, G, c); rounds = (S.nwg + G - 1) / G; reps = reps_; }
    __device__ bool next(int i, pg8::Unit& u) const { if (i >= rounds * reps) return false; return S.next(i % rounds, u); }
    __device__ __forceinline__ void a_ready(const pg8::Unit&) const {}
    __device__ __forceinline__ void done(const pg8::Unit&) const {}
};
namespace att {
constexpr int L_K = 0, L_V = 16384, L_FK = 32768, L_FLAG = 33280, L_UNIT = 33408, L_WSF = 33536, L_STG = 36864;
__device__ __forceinline__ int crow(int r, int hi) { return (r & 3) + 8 * (r >> 2) + 4 * hi; }
typedef short v4i16_t __attribute__((ext_vector_type(4)));
__device__ __forceinline__ s16x4 vtr(const LAS unsigned char* p) { return __builtin_bit_cast(s16x4, __builtin_amdgcn_ds_read_tr16_b64_v4i16((LAS v4i16_t*)p)); }
#define EXIT_THR (-48.f)
#define EX2(x) __builtin_amdgcn_exp2f(x)
#define LG2(x) __builtin_amdgcn_logf(x)
#define MFMA32(a, b, c) __builtin_amdgcn_mfma_f32_32x32x16_bf16((a), (b), (c), 0, 0, 0)

template <bool FOX>
__device__ __forceinline__ void unit(const bf16* __restrict__ H, const float* __restrict__ F, const unsigned* __restrict__ kmaxw, bf16* __restrict__ Y, int b, int h, int qb, LAS unsigned char* lds) {
    const int tid = threadIdx.x, lane = tid & 63, r32 = lane & 31, hi = lane >> 5;
    const int wid = __builtin_amdgcn_readfirstlane(tid >> 6);
    const int q0 = qb * 256, qw0 = q0 + 32 * wid;
    const size_t rowbase = (size_t)b * SEQ;
    const int colQ = (FOX ? 0 : 2048) + h * 64, colK = colQ + 512, colV = colQ + 1024, colG = colQ + 1536;
    const int bh = b * 8 + h;
    LAS float* wsf = (LAS float*)(lds + L_WSF + wid * 256);
    bf16x8 qr[4];
    { const bf16* qp = H + (rowbase + qw0 + r32) * HP + colQ + hi * 8;
#pragma unroll
        for (int d0 = 0; d0 < 4; ++d0) qr[d0] = *(const bf16x8*)(qp + d0 * 16); }
    float Fq = 0.f, qk = 0.f, m = -1e30f, l = 0.f, carry = 0.f;
    if (FOX) {
        Fq = F[(size_t)bh * SEQ + qw0 + r32];
        float ss = 0.f;
#pragma unroll
        for (int d0 = 0; d0 < 4; ++d0)
#pragma unroll
            for (int e = 0; e < 8; ++e) { const float v = bf2f((unsigned short)qr[d0][e]); ss += v * v; }
        ss += __shfl_xor(ss, 32);
        const float km = sqrtf(__uint_as_float(kmaxw[bh * 2]) + __uint_as_float(kmaxw[bh * 2 + 1]));
        qk = sqrtf(ss) * km * 1.02f + 1.0f;
    }
    f32x16 o0, o1;
#pragma unroll
    for (int r = 0; r < 16; ++r) { o0[r] = 0.f; o1[r] = 0.f; }
    bf16x8 tp0, tp1;
#pragma unroll
    for (int s = 0; s < 8; ++s) { const int kvl = 4 * hi + (s & 3) + 8 * (s >> 2); tp0[s] = (kvl > r32) ? (short)0x3F80 : (short)0; tp1[s] = (16 + kvl > r32) ? (short)0x3F80 : (short)0; }
    const int tmax = 4 * qb + 3, td = qw0 >> 6, qoff = qw0 & 63;
    const bf16* ksrc = H + (rowbase + lane) * HP + colK + wid * 8;
    const bf16* vsrc = H + (rowbase + (tid >> 3)) * HP + colV + (tid & 7) * 8;
    const float* fsrc = F + (size_t)bh * SEQ + (tid & 63);
    const int kdst = L_K + wid * 1024 + lane * 16;
    const int vdst = L_V + ((tid & 7) >> 2) * 4096 + (tid >> 3) * 64 + (tid & 3) * 16;
    u32x4 kreg, vreg; float freg = 0.f;
    { const size_t off = (size_t)tmax * 64 * HP;
        kreg = *(const u32x4*)(ksrc + off); vreg = *(const u32x4*)(vsrc + off); if (FOX && tid < 64) freg = fsrc[tmax * 64];
        *(LAS u32x4*)(lds + kdst) = kreg; *(LAS u32x4*)(lds + vdst) = vreg; if (FOX && tid < 64) ((LAS float*)(lds + L_FK))[tid] = freg; }
    __syncthreads();
    bool done = false;
    int it = 0;
    for (int t = tmax; t >= 0; --t, ++it) {
        const int buf = it & 1;
        if (t > 0) { const size_t off = (size_t)(t - 1) * 64 * HP; kreg = *(const u32x4*)(ksrc + off); vreg = *(const u32x4*)(vsrc + off); if (FOX && tid < 64) freg = fsrc[(t - 1) * 64]; }
        if (!done && t <= td) {
            const LAS unsigned char* Kb = lds + L_K + buf * 8192; const LAS unsigned char* Vb = lds + L_V + buf * 8192;
            f32x16 p0, p1;
            if (FOX) {
                const LAS float* fkp = (const LAS float*)(lds + L_FK + buf * 256) + 4 * hi;
#pragma unroll
                for (int g = 0; g < 4; ++g) { const f32x4 a = *(const LAS f32x4*)(fkp + 8 * g), c = *(const LAS f32x4*)(fkp + 32 + 8 * g);
#pragma unroll
                    for (int e = 0; e < 4; ++e) { p0[4 * g + e] = Fq - a[e]; p1[4 * g + e] = Fq - c[e]; } }
            } else {
#pragma unroll
                for (int r = 0; r < 16; ++r) { p0[r] = 0.f; p1[r] = 0.f; }
            }
            { const LAS unsigned char* kb = Kb + hi * 1024 + r32 * 16;
#pragma unroll
                for (int d0 = 0; d0 < 4; ++d0) { const bf16x8 a0 = *(const LAS bf16x8*)(kb + d0 * 2048), a1 = *(const LAS bf16x8*)(kb + d0 * 2048 + 512);
                    p0 = MFMA32(a0, qr[d0], p0); p1 = MFMA32(a1, qr[d0], p1); } }
            if (FOX) {
                if (t == td) {
#pragma unroll
                    for (int r = 0; r < 16; ++r) { const int kv = crow(r, hi); if (kv > qoff + r32) p0[r] = -INFINITY; if (kv + 32 > qoff + r32) p1[r] = -INFINITY; }
                }
                float rm = fmaxf(p0[0], p1[0]);
#pragma unroll
                for (int r = 1; r < 16; ++r) rm = fmaxf(rm, fmaxf(p0[r], p1[r]));
                rm = fmaxf(rm, __shfl_xor(rm, 32));
                const float mn = fmaxf(m, rm);
                if (__any(mn > m)) {
                    const float al = EX2(m - mn); l *= al;
                    if (hi == 0) wsf[r32] = al;
#pragma unroll
                    for (int r = 0; r < 16; ++r) { const float a = wsf[crow(r, hi)]; o0[r] *= a; o1[r] *= a; }
                }
                m = mn;
                float rs = 0.f;
#pragma unroll
                for (int r = 0; r < 16; ++r) { p0[r] = EX2(p0[r] - m); p1[r] = EX2(p1[r] - m); rs += p0[r] + p1[r]; }
                l += rs;
                const float fk0 = *(const LAS float*)(lds + L_FK + buf * 256);
                done = __all((qk + Fq - fk0 - m) < EXIT_THR);
            } else {
                f32x16 lb0, lb1;
#pragma unroll
                for (int r = 0; r < 16; ++r) {
                    { const float z = p0[r], sp = LG2(1.f + EX2(z)); p0[r] = -sp; lb0[r] = z - sp; }
                    { const float z = p1[r], sp = LG2(1.f + EX2(z)); p1[r] = -sp; lb1[r] = z - sp; }
                }
                if (t == td) {
#pragma unroll
                    for (int r = 0; r < 16; ++r) { const int kv = crow(r, hi); if (kv >= qoff + r32) { p0[r] = 0.f; lb0[r] = -INFINITY; } if (kv + 32 >= qoff + r32) { p1[r] = 0.f; lb1[r] = -INFINITY; } }
                }
                float s0 = 0.f, s1 = 0.f;
#pragma unroll
                for (int r = 0; r < 16; ++r) { s0 += p0[r]; s1 += p1[r]; }
                s0 += __shfl_xor(s0, 32); s1 += __shfl_xor(s1, 32);
                u32x4 bh_[4], bl_[4];
#pragma unroll
                for (int ks = 0; ks < 4; ++ks)
#pragma unroll
                    for (int j = 0; j < 4; ++j) { const int r = 8 * (ks & 1) + 2 * j; const float a = (ks < 2) ? p0[r] : p1[r], c = (ks < 2) ? p0[r + 1] : p1[r + 1];
                        const unsigned hp = pk2(a, c); bh_[ks][j] = hp; bl_[ks][j] = pk2(a - __uint_as_float(hp << 16), c - __uint_as_float(hp & 0xffff0000u)); }
                f32x16 L0, L1; const float c0 = carry + s1;
#pragma unroll
                for (int r = 0; r < 16; ++r) { L0[r] = c0; L1[r] = carry; }
                L0 = MFMA32(tp0, __builtin_bit_cast(bf16x8, bh_[0]), L0); L0 = MFMA32(tp1, __builtin_bit_cast(bf16x8, bh_[1]), L0);
                L1 = MFMA32(tp0, __builtin_bit_cast(bf16x8, bh_[2]), L1); L1 = MFMA32(tp1, __builtin_bit_cast(bf16x8, bh_[3]), L1);
                L0 = MFMA32(tp0, __builtin_bit_cast(bf16x8, bl_[0]), L0); L0 = MFMA32(tp1, __builtin_bit_cast(bf16x8, bl_[1]), L0);
                L1 = MFMA32(tp0, __builtin_bit_cast(bf16x8, bl_[2]), L1); L1 = MFMA32(tp1, __builtin_bit_cast(bf16x8, bl_[3]), L1);
#pragma unroll
                for (int r = 0; r < 16; ++r) { p0[r] = EX2(lb0[r] + L0[r]); p1[r] = EX2(lb1[r] + L1[r]); }
                carry += s0 + s1;
                done = __all(carry < EXIT_THR);
            }
            u32x4 pa[4];
#pragma unroll
            for (int j = 0; j < 4; ++j) { pa[0][j] = pk2(p0[2 * j], p0[2 * j + 1]); pa[1][j] = pk2(p0[8 + 2 * j], p0[9 + 2 * j]); pa[2][j] = pk2(p1[2 * j], p1[2 * j + 1]); pa[3][j] = pk2(p1[8 + 2 * j], p1[9 + 2 * j]); }
            const LAS unsigned char* vp = Vb + ((lane >> 4) & 1) * 32 + (lane & 3) * 8 + (4 * hi + ((lane & 15) >> 2)) * 64;
#pragma unroll
            for (int ks = 0; ks < 4; ++ks) {
                const s16x4 a0 = vtr(vp + ks * 1024), a1 = vtr(vp + ks * 1024 + 512), c0 = vtr(vp + 4096 + ks * 1024), c1 = vtr(vp + 4096 + ks * 1024 + 512);
                const bf16x8 v0 = (bf16x8){a0[0], a0[1], a0[2], a0[3], a1[0], a1[1], a1[2], a1[3]}, v1 = (bf16x8){c0[0], c0[1], c0[2], c0[3], c1[0], c1[1], c1[2], c1[3]};
                o0 = MFMA32(__builtin_bit_cast(bf16x8, pa[ks]), v0, o0); o1 = MFMA32(__builtin_bit_cast(bf16x8, pa[ks]), v1, o1);
            }
        }
        if (lane == 0) ((LAS unsigned*)(lds + L_FLAG))[buf * 8 + wid] = done ? 1u : 0u;
        if (t > 0) { const int nb = (buf ^ 1) * 8192;
            *(LAS u32x4*)(lds + kdst + nb) = kreg; *(LAS u32x4*)(lds + vdst + nb) = vreg; if (FOX && tid < 64) ((LAS float*)(lds + L_FK + (buf ^ 1) * 256))[tid] = freg; }
        __syncthreads();
        const u32x4 f0 = *(const LAS u32x4*)(lds + L_FLAG + buf * 32), f1 = *(const LAS u32x4*)(lds + L_FLAG + buf * 32 + 16);
        if ((f0.x & f0.y & f0.z & f0.w & f1.x & f1.y & f1.z & f1.w) != 0u) break;
    }
    if (FOX) {
        l += __shfl_xor(l, 32);
        if (hi == 0) wsf[r32] = 1.f / l;
#pragma unroll
        for (int r = 0; r < 16; ++r) { const float a = wsf[crow(r, hi)]; o0[r] *= a; o1[r] *= a; }
    }
    LAS float* stg = (LAS float*)(lds + L_STG + wid * 8192);
#pragma unroll
    for (int r = 0; r < 16; ++r) { const int orow = crow(r, hi); stg[orow * 64 + r32] = o0[r]; stg[orow * 64 + 32 + r32] = o1[r]; }
#pragma unroll
    for (int i = 0; i < 4; ++i) { const int row = i * 8 + (lane >> 3), ch = lane & 7;
        const f32x4 a = *(const LAS f32x4*)(stg + row * 64 + ch * 8), c = *(const LAS f32x4*)(stg + row * 64 + ch * 8 + 4);
        const u32x4 g = *(const u32x4*)(H + (rowbase + qw0 + row) * HP + colG + ch * 8);
        u32x4 w;
        w.x = pk2(a[0] * silu_f(__uint_as_float(g.x << 16)), a[1] * silu_f(__uint_as_float(g.x & 0xffff0000u)));
        w.y = pk2(a[2] * silu_f(__uint_as_float(g.y << 16)), a[3] * silu_f(__uint_as_float(g.y & 0xffff0000u)));
        w.z = pk2(c[0] * silu_f(__uint_as_float(g.z << 16)), c[1] * silu_f(__uint_as_float(g.z & 0xffff0000u)));
        w.w = pk2(c[2] * silu_f(__uint_as_float(g.w << 16)), c[3] * silu_f(__uint_as_float(g.w & 0xffff0000u)));
        *(u32x4*)(Y + (rowbase + qw0 + row) * DMODEL + (FOX ? 0 : 512) + h * 64 + ch * 8) = w; }
}
}

#define XB_TMO      128
#define XB_XCNT(j)  (256  + 64 * (j))
#define XB_XSUB(j)  (1280 + 64 * (j))
#define XB_XGEN(j)  (2304 + 64 * (j))
#define XB_TOP      3328
#define XB_TOPGEN   3392
#define XCD_BAR_WORDS 3456
#define XB_SPIN_CAP (1u << 18)

__device__ __forceinline__ unsigned xb_ld(unsigned* p)              { return __hip_atomic_load(p, __ATOMIC_RELAXED, __HIP_MEMORY_SCOPE_AGENT); }
__device__ __forceinline__ unsigned xb_add(unsigned* p, unsigned v) { return __hip_atomic_fetch_add(p, v, __ATOMIC_RELAXED, __HIP_MEMORY_SCOPE_AGENT); }
__device__ __forceinline__ unsigned xb_xcc_id() { return (unsigned)__builtin_amdgcn_s_getreg((3 << 11) | 20) & 0xFu; }
#define XB_SPIN(cond, bar) do { unsigned _sp = 0; while (cond) { __builtin_amdgcn_s_sleep(1); \
    if ((++_sp & 255u) == 0u) { if (xb_ld(&(bar)[XB_TMO])) break; if (_sp > XB_SPIN_CAP) { atomicAdd(&(bar)[XB_TMO], 1u); break; } } } } while (0)

struct XcdBarrier {
    unsigned* bar; unsigned x;
    volatile LAS unsigned* st;
};

__device__ __forceinline__ XcdBarrier xcd_barrier_post(unsigned* bar, volatile LAS unsigned* st) {
    XcdBarrier b; b.bar = bar; b.x = xb_xcc_id(); b.st = st;
    if (threadIdx.x == 0) (void)xb_add(&bar[XB_XCNT(b.x)], 1u);
    return b;
}
__device__ __forceinline__ void xcd_barrier_complete(unsigned* bar, unsigned x, unsigned& nloc, unsigned& nx) {
    const unsigned G = gridDim.x * gridDim.y * gridDim.z;
    unsigned sum, cnt, mine, sp = 0u;
    for (;;) {
        sum = 0u; cnt = 0u; mine = 0u;
#pragma unroll
        for (unsigned j = 0; j < 16; ++j) { const unsigned c = xb_ld(&bar[XB_XCNT(j)]); sum += c; cnt += (c > 0u) ? 1u : 0u; mine = (j == x) ? c : mine; }
        if (sum == G) break;
        __builtin_amdgcn_s_sleep(1);
        if ((++sp & 255u) == 0u) { if (xb_ld(&bar[XB_TMO])) break; if (sp > XB_SPIN_CAP) { atomicAdd(&bar[XB_TMO], 1u); break; } }
    }
    nloc = mine > 0u ? mine : 1u; nx = cnt > 0u ? cnt : 1u;
}

__device__ __forceinline__ void xcd_barrier(const XcdBarrier& b) {
    asm volatile("s_waitcnt vmcnt(0)" ::: "memory");
    __syncthreads();
    if (threadIdx.x == 0) {
        unsigned* bar = b.bar;
        __builtin_amdgcn_s_waitcnt(0);
        unsigned nloc = b.st[0], nx = b.st[1];
        if (nloc == 0u) { xcd_barrier_complete(bar, b.x, nloc, nx); b.st[0] = nloc; b.st[1] = nx; }
        const unsigned old = xb_add(&bar[XB_XSUB(b.x)], 1u);
        const unsigned gen = old / nloc;
        if (old + 1u == (gen + 1u) * nloc) {
            __builtin_amdgcn_fence(__ATOMIC_RELEASE, "agent");
            asm volatile("s_waitcnt vmcnt(0)" ::: "memory");
            const unsigned og = xb_add(&bar[XB_TOP], 1u);
            const unsigned tg = og / nx;
            if (og + 1u == (tg + 1u) * nx) xb_add(&bar[XB_TOPGEN], 1u);
            else XB_SPIN(xb_ld(&bar[XB_TOPGEN]) == tg, bar);
            __builtin_amdgcn_fence(__ATOMIC_ACQUIRE, "agent");
            xb_add(&bar[XB_XGEN(b.x)], 1u);
            asm volatile("s_waitcnt vmcnt(0)" ::: "memory");
        } else {
            XB_SPIN(xb_ld(&bar[XB_XGEN(b.x)]) == gen, bar);
            __builtin_amdgcn_fence(__ATOMIC_ACQUIRE, "agent");
            asm volatile("s_waitcnt vmcnt(0)" ::: "memory");
        }
    }
    __syncthreads();
}


struct KArgs { const float* x; const float* c; const float* w_ada; const float* b_ada; const float* w_in; const float* b_f; const float* w_out; const float* ln_g; const float* ln_b; float* out; unsigned char* ws; int ph_lo; int ph_hi; };

__device__ __forceinline__ void transpose_item(const float* __restrict__ W, int ldw, int srccol0, int k0, bf16* __restrict__ WT, int K, int dstrow0, float scale, LAS float* scr, int lane) {
#pragma unroll 8
    for (int i = 0; i < 32; ++i) { const int kk = 2 * i + (lane >> 5); scr[kk * 33 + (lane & 31)] = W[(size_t)(k0 + kk) * ldw + srccol0 + (lane & 31)]; }
    asm volatile("s_waitcnt lgkmcnt(0)" ::: "memory");
    const int c = lane & 7;
#pragma unroll
    for (int j = 0; j < 4; ++j) { const int n = (lane >> 3) + 8 * j; const LAS float* s = scr + (8 * c) * 33 + n;
        u32x4 o; o.x = pk2(s[0] * scale, s[33] * scale); o.y = pk2(s[66] * scale, s[99] * scale); o.z = pk2(s[132] * scale, s[165] * scale); o.w = pk2(s[198] * scale, s[231] * scale);
        *(u32x4*)(WT + (size_t)(dstrow0 + n) * K + k0 + 8 * c) = o; }
    asm volatile("s_waitcnt lgkmcnt(0)" ::: "memory");
}

__global__ void __launch_bounds__(512) fwd_kernel(KArgs a) {
    extern __shared__ __attribute__((aligned(16))) unsigned char lds_raw[];
    LAS unsigned char* lds = (LAS unsigned char*)lds_raw;
    cg::grid_group grid = cg::this_grid();
    const int tid = threadIdx.x, lane = tid & 63, wid = __builtin_amdgcn_readfirstlane(tid >> 6);
    const int blk = blockIdx.x, G = gridDim.x;
    unsigned char* ws = a.ws;
    unsigned* ctl = (unsigned*)(ws + WS_CTL);
    bf16* WTin = (bf16*)(ws + WS_WTIN); bf16* WTout = (bf16*)(ws + WS_WTOUT);
    float* modv = (float*)(ws + WS_MOD); float* LF = (float*)(ws + WS_LF); float* Fc = (float*)(ws + WS_F);
    bf16* U = (bf16*)(ws + WS_U); bf16* Hb = (bf16*)(ws + WS_H); bf16* Yb = (bf16*)(ws + WS_Y);
    volatile LAS unsigned* xbst = (volatile LAS unsigned*)(lds + 131072);
    if (tid < 2) xbst[tid] = 0u;
    __syncthreads();
    XcdBarrier xbar = xcd_barrier_post(ctl + CW_BAR, xbst);
    if (a.ph_lo > 1000) grid.sync();
    const int lo = a.ph_lo, hi_ = a.ph_hi;
#define IN(k) (lo <= (k) && (k) < hi_)
#define BOTH(k) (IN(k) && IN((k) + 1))

    PHASE_REP(0) { if (rep) grid.sync();
    if (IN(0)) {
        if (blk < 96) {
            LAS float* sc = (LAS float*)lds; LAS float* red = (LAS float*)(lds + 8192);
            for (int i = tid; i < 2048; i += 512) sc[i] = silu_f(a.c[i]);
            __syncthreads();
            const int n = tid & 31, kg = tid >> 5, col = 32 * blk + n;
            float a0 = 0.f, a1 = 0.f;
#pragma unroll 8
            for (int k = 64 * kg; k < 64 * kg + 64; ++k) { const float w = a.w_ada[(size_t)k * 3072 + col]; a0 += sc[k] * w; a1 += sc[1024 + k] * w; }
            red[(kg * 32 + n) * 2] = a0; red[(kg * 32 + n) * 2 + 1] = a1;
            __syncthreads();
            if (tid < 64) { const int nn = tid & 31, bb = tid >> 5; float s = a.b_ada[32 * blk + nn];
                for (int g = 0; g < 16; ++g) s += red[(g * 32 + nn) * 2 + bb];
                modv[bb * 3072 + 32 * blk + nn] = s; }
            __syncthreads();
        }
        LAS float* scr = (LAS float*)(lds + wid * 16384);
        const int gw = blk * 8 + wid, NGW = G * 8;
        for (int it = gw; it < 2048 + 512; it += NGW) {
            if (it < 2048) { const int nb = it & 127, kb = it >> 7, n0 = 32 * nb;
                const float scl = (n0 < 512 || (n0 >= 2048 && n0 < 2560)) ? C2 : 1.f;
                transpose_item(a.w_in, INW, n0 + (n0 >= 2048 ? 8 : 0), 64 * kb, WTin, 1024, n0, scl, scr, lane);
            } else { const int r = it - 2048, nb = r & 31, kb = r >> 5;
                transpose_item(a.w_out, 1024, 32 * nb, 64 * kb, WTout, 1024, 32 * nb, 1.f, scr, lane); }
        }
        __syncthreads();
    }
    }
    if (BOTH(0)) xcd_barrier(xbar);

    PHASE_REP(1) { if (rep) grid.sync();
    if (IN(1)) {
        LAS float* wff = (LAS float*)lds;
        for (int i = tid; i < 2048; i += 512) { const int col = i >> 1, half = i & 1; const f32x4 v = *(const f32x4*)(a.w_in + (size_t)col * INW + 2048 + 4 * half);
            wff[(4 * half + 0) * 1024 + col] = v[0]; wff[(4 * half + 1) * 1024 + col] = v[1]; wff[(4 * half + 2) * 1024 + col] = v[2]; wff[(4 * half + 3) * 1024 + col] = v[3]; }
        __syncthreads();
        for (int rb = blk; rb < MROWS / 64; rb += G) {
            const int b = rb >> 7;
            f32x4 sc1[4], sh[4];
#pragma unroll
            for (int j = 0; j < 4; ++j) { sh[j] = *(const f32x4*)(modv + b * 3072 + 4 * (lane + 64 * j)); sc1[j] = *(const f32x4*)(modv + b * 3072 + 1024 + 4 * (lane + 64 * j)) + 1.f; }
            const float bfl = a.b_f[lane & 7];
            for (int i = 0; i < 8; ++i) {
                const int row = rb * 64 + wid * 8 + i;
                const f32x4* xr = (const f32x4*)(a.x + (size_t)row * DMODEL) + lane;
                f32x4 v[4]; float s = 0.f;
#pragma unroll
                for (int j = 0; j < 4; ++j) { v[j] = xr[64 * j]; s += (v[j][0] + v[j][1]) + (v[j][2] + v[j][3]); }
                const float mean = wave_sum(s) * (1.f / DMODEL); float s2 = 0.f;
#pragma unroll
                for (int j = 0; j < 4; ++j) { v[j] = v[j] - mean; s2 += (v[j][0] * v[j][0] + v[j][1] * v[j][1]) + (v[j][2] * v[j][2] + v[j][3] * v[j][3]); }
                const float rstd = 1.f / sqrtf(wave_sum(s2) * (1.f / DMODEL) + LN_EPS);
                u32x2* o8 = (u32x2*)(U + (size_t)row * DMODEL) + lane;
#pragma unroll
                for (int j = 0; j < 4; ++j) { v[j] = v[j] * rstd * sc1[j] + sh[j]; u32x2 w; w.x = pk2(v[j][0], v[j][1]); w.y = pk2(v[j][2], v[j][3]); o8[64 * j] = w; }
                float ffv = 0.f;
#pragma unroll
                for (int q = 0; q < 8; ++q) { float d = 0.f;
#pragma unroll
                    for (int j = 0; j < 4; ++j) { const f32x4 w = *(const LAS f32x4*)(wff + q * 1024 + 4 * (lane + 64 * j)); d += (v[j][0] * w[0] + v[j][1] * w[1]) + (v[j][2] * w[2] + v[j][3] * w[3]); }
                    d = wave_sum(d); if (lane == q) ffv = d; }
                if (lane < 8) { const float t = ffv + bfl; const float ls = fminf(t, 0.f) - log1pf(__expf(-fabsf(t))); LF[(size_t)(b * 8 + lane) * SEQ + (row & (SEQ - 1))] = ls * LOG2E; }
            }
        }
        __syncthreads();
    }
    }
    if (BOTH(1)) xcd_barrier(xbar);

    {
    if (IN(2)) {
        for (int sq = blk; sq < 16; sq += G) {
            const float* src = LF + (size_t)sq * SEQ + tid * 16; f32x4 v[4]; float run = 0.f;
#pragma unroll
            for (int j = 0; j < 4; ++j) { v[j] = *(const f32x4*)(src + 4 * j);
#pragma unroll
                for (int e = 0; e < 4; ++e) { run += v[j][e]; v[j][e] = run; } }
            float xs = run;
#pragma unroll
            for (int o = 1; o < 64; o <<= 1) { const float y = __shfl_up(xs, o); if (lane >= o) xs += y; }
            LAS float* wt = (LAS float*)lds;
            if (lane == 63) wt[wid] = xs;
            __syncthreads();
            float off = xs - run;
            for (int w = 0; w < wid; ++w) off += wt[w];
            float* dst = Fc + (size_t)sq * SEQ + tid * 16;
#pragma unroll
            for (int j = 0; j < 4; ++j) *(f32x4*)(dst + 4 * j) = v[j] + off;
            __syncthreads();
        }
        pg8::Gemm g{U, WTin, MROWS, HP, 1024}; StaticOrderRep S; S.init(MROWS, HP, G, blk, REPK == 2 ? 2 : 1);
        EpiH E{Hb, ctl + CW_KMAX};
        pg8::gemm_phase<EpiH, StaticOrderRep, true, true>(lds, g, S, E);
    }
    }
    if (BOTH(2)) xcd_barrier(xbar);

    PHASE_REP(3) { if (rep) grid.sync();
    if (IN(3)) {
        for (;;) {
            if (tid == 0) *(LAS unsigned*)(lds + att::L_UNIT) = atomicAdd(ctl + CW_CTR + rep, 1u);
            __syncthreads();
            const unsigned u = (unsigned)__builtin_amdgcn_readfirstlane(*(const LAS unsigned*)(lds + att::L_UNIT));
            if (u >= 1024u) break;
            const int v = (int)(u & 511u), qb = 31 - (v >> 4), bh = v & 15;
            if (u < 512u) att::unit<true>(Hb, Fc, ctl + CW_KMAX, Yb, bh >> 3, bh & 7, qb, lds);
            else att::unit<false>(Hb, Fc, ctl + CW_KMAX, Yb, bh >> 3, bh & 7, qb, lds);
            __syncthreads();
        }
    }
    }
    if (BOTH(3)) xcd_barrier(xbar);

    {
    if (IN(4)) {
        pg8::Gemm g{Yb, WTout, MROWS, DMODEL, 1024}; StaticOrderRep S; S.init(MROWS, DMODEL, G, blk, REPK == 4 ? 2 : 1);
        EpiResid E{a.x, modv, a.out};
        pg8::gemm_phase<EpiResid, StaticOrderRep, true, true>(lds, g, S, E);
    }
    }
    if (BOTH(4)) xcd_barrier(xbar);

    if (IN(5)) {
        f32x4 gv[4], bv[4];
#pragma unroll
        for (int j = 0; j < 4; ++j) { gv[j] = *(const f32x4*)(a.ln_g + 4 * (lane + 64 * j)); bv[j] = *(const f32x4*)(a.ln_b + 4 * (lane + 64 * j)); }
        for (int row = blk * 8 + wid; row < MROWS; row += G * 8) {
            f32x4* xr = (f32x4*)(a.out + (size_t)row * DMODEL) + lane;
            f32x4 v[4]; float s = 0.f;
#pragma unroll
            for (int j = 0; j < 4; ++j) { v[j] = xr[64 * j]; s += (v[j][0] + v[j][1]) + (v[j][2] + v[j][3]); }
            const float mean = wave_sum(s) * (1.f / DMODEL); float s2 = 0.f;
#pragma unroll
            for (int j = 0; j < 4; ++j) { v[j] = v[j] - mean; s2 += (v[j][0] * v[j][0] + v[j][1] * v[j][1]) + (v[j][2] * v[j][2] + v[j][3] * v[j][3]); }
            const float rstd = 1.f / sqrtf(wave_sum(s2) * (1.f / DMODEL) + LN_EPS);
#pragma unroll
            for (int j = 0; j < 4; ++j) xr[64 * j] = v[j] * rstd * gv[j] + bv[j];
        }
    }
#undef IN
#undef BOTH
}

extern "C" void kernel_launch(void* const* d_in, const int* in_sizes, int n_in, void* d_out, int out_size, void* d_ws, size_t ws_size, hipStream_t stream) {
    static int grid = 0;
    if (grid == 0) {
        if (n_in != 9 || out_size != MROWS * DMODEL || ws_size < WS_END) { fprintf(stderr, "kernel_launch: unexpected shapes (n_in %d, out %d, ws %zu)\n", n_in, out_size, ws_size); grid = -1; return; }
        if (hipFuncSetAttribute((const void*)fwd_kernel, hipFuncAttributeMaxDynamicSharedMemorySize, LDS_BYTES) != hipSuccess) { fprintf(stderr, "kernel_launch: hipFuncSetAttribute failed\n"); grid = -1; return; }
        int dev = 0, cus = 0, per_cu = 0;
        (void)hipGetDevice(&dev); (void)hipDeviceGetAttribute(&cus, hipDeviceAttributeMultiprocessorCount, dev);
        if (hipOccupancyMaxActiveBlocksPerMultiprocessor(&per_cu, (const void*)fwd_kernel, 512, LDS_BYTES) != hipSuccess || per_cu < 1) { fprintf(stderr, "kernel_launch: occupancy query says %d blocks per CU\n", per_cu); per_cu = 1; }
        (void)hipGetLastError();
        grid = cus > 0 ? cus : 256;
    }
    if (grid < 0) return;
    if (hipMemsetAsync((char*)d_ws + WS_CTL, 0, CW_WORDS * 4, stream) != hipSuccess) { fprintf(stderr, "kernel_launch: memset failed\n"); return; }
    KArgs a{};
    a.x = (const float*)d_in[0]; a.c = (const float*)d_in[1]; a.w_ada = (const float*)d_in[2]; a.b_ada = (const float*)d_in[3]; a.w_in = (const float*)d_in[4];
    a.b_f = (const float*)d_in[5]; a.w_out = (const float*)d_in[6]; a.ln_g = (const float*)d_in[7]; a.ln_b = (const float*)d_in[8];
    a.out = (float*)d_out; a.ws = (unsigned char*)d_ws;
#if N_LAUNCHES == 1
    a.ph_lo = 0; a.ph_hi = 6;
    void* args[] = {&a};
    const hipError_t e = hipLaunchCooperativeKernel((const void*)fwd_kernel, dim3(grid), dim3(512), args, LDS_BYTES, stream);
    if (e != hipSuccess) fprintf(stderr, "kernel_launch: cooperative launch failed: %s (grid %d)\n", hipGetErrorString(e), grid);
#else
    for (int p = 0; p < 6; ++p) { a.ph_lo = p; a.ph_hi = p + 1; hipLaunchKernelGGL(fwd_kernel, dim3(grid), dim3(512), LDS_BYTES, stream, a); }
#endif
}
```
